# Optimizing an MI355X kernel written in HIP

```python
import math
import jax, jax.numpy as jnp
from jax import lax
import numpy as np

D_MODEL = 1024
BATCH = 16
SEQ = 2048
DEPTH = 4
DEC_BATCH = 8
DEC_SEQ = 2048
PAST_LEN = 128

RET_HEADS = 4
RET_QK_DIM = 128
RET_V_DIM = 256
RET_QK_W = RET_HEADS * RET_QK_DIM
RET_V_W = RET_HEADS * RET_V_DIM
RET_CHUNK = 128
MLA_HEADS = 8
MLA_NOPE = 128
MLA_ROPE = 64
MLA_V = 128
Q_LORA = 256
KV_LORA = 128
MLA_QK = MLA_NOPE + MLA_ROPE
MLA_V_W = MLA_HEADS * MLA_V
Q_BLOCK = 128
IN_SPLITS = (RET_QK_W, RET_QK_W, RET_V_W, RET_V_W, Q_LORA, KV_LORA, MLA_ROPE, D_MODEL, D_MODEL)
IN_WIDTH = sum(IN_SPLITS)
D_FF = 2816
CONV_W = 3
ROPE_THETA = 10000.0
LN_EPS = 1e-5
RMS_EPS = 1e-6
DEEPNORM_ALPHA = (2.0 * DEPTH) ** 0.25
DEEPNORM_BETA = (8.0 * DEPTH) ** -0.25

kernel_name = "hybrid_retention_mla_convffn_encoder"


def _layernorm(x):
    xf = x.astype(jnp.float32)
    mu = jnp.mean(xf, axis=-1, keepdims=True)
    xc = xf - mu
    var = jnp.mean(xc * xc, axis=-1, keepdims=True)
    return (xc * lax.rsqrt(var + LN_EPS)).astype(x.dtype)


def _rmsnorm(x, g):
    xf = x.astype(jnp.float32)
    y = xf * lax.rsqrt(jnp.mean(xf * xf, axis=-1, keepdims=True) + RMS_EPS)
    return y.astype(x.dtype) * g


def _rope_tables(seq, dim):
    inv = 1.0 / (ROPE_THETA ** (jnp.arange(0, dim, 2, dtype=jnp.float32) / dim))
    ang = jnp.arange(seq, dtype=jnp.float32)[:, None] * inv[None, :]
    return jnp.cos(ang), jnp.sin(ang)


def _apply_rope(x, cos, sin):
    extra = x.ndim - 3
    c = cos.reshape(cos.shape[0], *([1] * extra), cos.shape[-1])
    s = sin.reshape(sin.shape[0], *([1] * extra), sin.shape[-1])
    xf = x.astype(jnp.float32)
    x1, x2 = jnp.split(xf, 2, axis=-1)
    return jnp.concatenate([x1 * c - x2 * s, x2 * c + x1 * s], axis=-1).astype(x.dtype)


def _retention_one_direction(q, k, v, log_gamma, strict):
    B, S, H, DK = q.shape
    DV = v.shape[-1]
    C = RET_CHUNK
    N = S // C
    qc = q.reshape(B, N, C, H, DK)
    kc = k.reshape(B, N, C, H, DK)
    vc = v.reshape(B, N, C, H, DV)
    idx = jnp.arange(C, dtype=jnp.float32)
    diff = idx[:, None] - idx[None, :]
    keep = (diff > 0) if strict else (diff >= 0)
    decay = jnp.where(keep[None], jnp.exp(log_gamma[:, None, None] * jnp.maximum(diff, 0.0)[None]), 0.0)
    scores = jnp.einsum('bnqhd,bnkhd->bnhqk', qc, kc) * decay[None, None]
    intra = jnp.einsum('bnhqk,bnkhe->bnqhe', scores, vc)
    q_decay = jnp.exp(log_gamma[None, :] * (idx[:, None] + 1.0))
    k_decay = jnp.exp(log_gamma[None, :] * (C - 1.0 - idx)[:, None])
    chunk_decay = jnp.exp(log_gamma * C)
    kv_chunk = jnp.einsum('bnchd,bnche->nbhde', kc * k_decay[None, None, :, :, None], vc)

    def step(state, kv_n):
        return chunk_decay[None, :, None, None] * state + kv_n, state

    _, states = lax.scan(step, jnp.zeros((B, H, DK, DV), jnp.float32), kv_chunk)
    cross = jnp.einsum('bnchd,nbhde->bnche', qc * q_decay[None, None, :, :, None], states)
    return (intra + cross).reshape(B, S, H, DV)


def _bidirectional_retention(q, k, v, decay_fwd, decay_bwd):
    dt = v.dtype
    qf, kf, vf = q.astype(jnp.float32), k.astype(jnp.float32), v.astype(jnp.float32)
    lg_f = jnp.log(jax.nn.sigmoid(decay_fwd.astype(jnp.float32)))
    lg_b = jnp.log(jax.nn.sigmoid(decay_bwd.astype(jnp.float32)))
    o_f = _retention_one_direction(qf, kf, vf, lg_f, False)
    o_b = jnp.flip(_retention_one_direction(jnp.flip(qf, 1), jnp.flip(kf, 1), jnp.flip(vf, 1), lg_b, True), 1)
    return (o_f + o_b).astype(dt)


def _mla_attention(q_nope, q_rope, k_nope, k_rope, v):
    B, S, H, _ = q_nope.shape
    NB = S // Q_BLOCK
    scale = MLA_QK ** -0.5

    def blockify(t):
        return jnp.moveaxis(t.reshape(B, NB, Q_BLOCK, *t.shape[2:]), 1, 0)

    def one_block(args):
        qn, qr = args
        s = jnp.einsum('bqhd,bkhd->bhqk', qn, k_nope) + jnp.einsum('bqhr,bkr->bhqk', qr, k_rope)
        p = jax.nn.softmax(s.astype(jnp.float32) * scale, axis=-1).astype(v.dtype)
        return jnp.einsum('bhqk,bkhe->bqhe', p, v)

    out = lax.map(one_block, (blockify(q_nope), blockify(q_rope)))
    return jnp.moveaxis(out, 0, 1).reshape(B, S, H * MLA_V)


def _dwconv3(a, w, b):
    ap = jnp.pad(a, ((0, 0), (1, 1), (0, 0)))
    return ap[:, :-2] * w[0] + ap[:, 1:-1] * w[1] + ap[:, 2:] * w[2] + b


def _encoder_layer(x, c, w_ada, b_ada, w_in, ret_decay_fwd, ret_decay_bwd, ret_gn_g, w_ret_o,
                   q_norm_g, kv_norm_g, w_uq, w_uk, w_uv, w_mla_o, w_out, ln1_g, ln1_b,
                   w_up, conv_w, conv_b, w_down, ln2_g, ln2_b):
    B, S, D = x.shape
    ada = jax.nn.silu(c) @ w_ada + b_ada
    sh1, sc1, g1, sh2, sc2, g2 = jnp.split(ada[:, None, :], 6, axis=-1)
    cos_r, sin_r = _rope_tables(S, RET_QK_DIM)
    cos_m, sin_m = _rope_tables(S, MLA_ROPE)

    h = _layernorm(x) * (1.0 + sc1) + sh1
    proj = h @ w_in
    offs, acc = [], 0
    for w in IN_SPLITS[:-1]:
        acc += w
        offs.append(acc)
    rq, rk, rv, rg, dq, dkv, kr, gA, gB = jnp.split(proj, offs, axis=-1)

    rq = _apply_rope(rq.reshape(B, S, RET_HEADS, RET_QK_DIM), cos_r, sin_r)
    rk = _apply_rope(rk.reshape(B, S, RET_HEADS, RET_QK_DIM), cos_r, sin_r) * (RET_QK_DIM ** -0.5)
    rv = rv.reshape(B, S, RET_HEADS, RET_V_DIM)
    ro = _bidirectional_retention(rq, rk, rv, ret_decay_fwd, ret_decay_bwd)
    ro = _layernorm(ro).reshape(B, S, RET_V_W) * ret_gn_g
    y_a = (jax.nn.silu(rg) * ro) @ w_ret_o

    cq = _rmsnorm(dq, q_norm_g)
    qm = (cq @ w_uq).reshape(B, S, MLA_HEADS, MLA_QK)
    q_nope, q_rope = qm[..., :MLA_NOPE], _apply_rope(qm[..., MLA_NOPE:], cos_m, sin_m)
    ckv = _rmsnorm(dkv, kv_norm_g)
    k_nope = (ckv @ w_uk).reshape(B, S, MLA_HEADS, MLA_NOPE)
    v_m = (ckv @ w_uv).reshape(B, S, MLA_HEADS, MLA_V)
    k_rope = _apply_rope(kr, cos_m, sin_m)
    y_b = _mla_attention(q_nope, q_rope, k_nope, k_rope, v_m) @ w_mla_o

    merged = jax.nn.sigmoid(gA) * y_a + jax.nn.sigmoid(gB) * y_b
    f = merged @ w_out
    x = _layernorm(DEEPNORM_ALPHA * x + (1.0 + g1) * f) * ln1_g + ln1_b

    h = _layernorm(x) * (1.0 + sc2) + sh2
    a, bgate = jnp.split(h @ w_up, 2, axis=-1)
    a = _dwconv3(a, conv_w, conv_b)
    y = (jax.nn.gelu(a, approximate=False) * bgate) @ w_down
    x = _layernorm(DEEPNORM_ALPHA * x + (1.0 + g2) * y) * ln2_g + ln2_b
    return x


def setup_inputs(seed: int = 0) -> dict:
    key = jax.random.key(seed)
    ks = jax.random.split(key, 32)
    nrm = lambda k, shp, s: jax.random.normal(k, shp, jnp.float32) * s
    L, D = DEPTH, D_MODEL
    base_decay = jnp.log(2.0 ** (5.0 + jnp.arange(RET_HEADS, dtype=jnp.float32)) - 1.0)
    return {
        "x_prompt": nrm(ks[0], (BATCH, SEQ, D), 1.0),
        "x_sample": nrm(ks[1], (DEC_BATCH, DEC_SEQ, D), 1.0),
        "c_prompt": nrm(ks[2], (BATCH, D), 1.0),
        "c_sample": nrm(ks[3], (DEC_BATCH, D), 1.0),
        "w_ada": nrm(ks[4], (L, D, 6 * D), 0.1 * D ** -0.5),
        "b_ada": nrm(ks[5], (L, 6 * D), 0.01),
        "w_in": nrm(ks[6], (L, D, IN_WIDTH), D ** -0.5),
        "ret_decay_fwd": base_decay[None] + nrm(ks[7], (L, RET_HEADS), 0.01),
        "ret_decay_bwd": base_decay[None] + nrm(ks[8], (L, RET_HEADS), 0.01),
        "ret_gn_g": 1.0 + nrm(ks[9], (L, RET_V_W), 0.01),
        "w_ret_o": nrm(ks[10], (L, RET_V_W, D), RET_V_W ** -0.5),
        "q_norm_g": 1.0 + nrm(ks[11], (L, Q_LORA), 0.01),
        "kv_norm_g": 1.0 + nrm(ks[12], (L, KV_LORA), 0.01),
        "w_uq": nrm(ks[13], (L, Q_LORA, MLA_HEADS * MLA_QK), Q_LORA ** -0.5),
        "w_uk": nrm(ks[14], (L, KV_LORA, MLA_HEADS * MLA_NOPE), KV_LORA ** -0.5),
        "w_uv": nrm(ks[15], (L, KV_LORA, MLA_V_W), KV_LORA ** -0.5),
        "w_mla_o": nrm(ks[16], (L, MLA_V_W, D), MLA_V_W ** -0.5),
        "w_out": nrm(ks[17], (L, D, D), DEEPNORM_BETA * D ** -0.5),
        "ln1_g": 1.0 + nrm(ks[18], (L, D), 0.01),
        "ln1_b": nrm(ks[19], (L, D), 0.01),
        "w_up": nrm(ks[20], (L, D, 2 * D_FF), D ** -0.5),
        "conv_w": nrm(ks[21], (L, CONV_W, D_FF), CONV_W ** -0.5),
        "conv_b": nrm(ks[22], (L, D_FF), 0.01),
        "w_down": nrm(ks[23], (L, D_FF, D), DEEPNORM_BETA * D_FF ** -0.5),
        "ln2_g": 1.0 + nrm(ks[24], (L, D), 0.01),
        "ln2_b": nrm(ks[25], (L, D), 0.01),
    }


def reference(x_prompt, x_sample, c_prompt, c_sample, w_ada, b_ada, w_in, ret_decay_fwd, ret_decay_bwd,
              ret_gn_g, w_ret_o, q_norm_g, kv_norm_g, w_uq, w_uk, w_uv, w_mla_o, w_out, ln1_g, ln1_b,
              w_up, conv_w, conv_b, w_down, ln2_g, ln2_b):
    params = (w_ada, b_ada, w_in, ret_decay_fwd, ret_decay_bwd, ret_gn_g, w_ret_o, q_norm_g, kv_norm_g,
              w_uq, w_uk, w_uv, w_mla_o, w_out, ln1_g, ln1_b, w_up, conv_w, conv_b, w_down, ln2_g, ln2_b)
    y_prompt, y_sample = x_prompt, x_sample
    for l in range(DEPTH):
        layer_params = [p[l] for p in params]
        y_prompt = _encoder_layer(y_prompt, c_prompt, *layer_params)
        y_sample = _encoder_layer(y_sample, c_sample, *layer_params)
    return (y_prompt, y_sample)
```

```cpp
#include <hip/hip_runtime.h>
#include <hip/hip_cooperative_groups.h>
#include <cstdio>
#include <cstdint>
namespace cg = cooperative_groups;
namespace pg8 {
#define PG8_LAS __attribute__((address_space(3)))
typedef unsigned short bf16_t;
typedef short bf16x8 __attribute__((ext_vector_type(8)));
typedef float f32x4 __attribute__((ext_vector_type(4)));
typedef unsigned u32x4 __attribute__((ext_vector_type(4)));
constexpr int BM = 256, BK = 64, HALF = 128, HTB = HALF * BK * 2  , STAGE_BYTES = 8 * HTB, NXCD = 8, WGM = 8;

__host__ __device__ __forceinline__ int lds_byte(int r, int c) { const int st = (r >> 4) * 2 + (c >> 5), rr = r & 15, cc = c & 31, ob = rr * 64 + cc * 2; return st * 1024 + (ob ^ (((ob >> 9) & 1) << 5)); }
__host__ __device__ __forceinline__ void stage_rc(int b, int& R, int& C) { const int st = b / 1024, sb = b % 1024, swz = sb ^ (((sb >> 9) & 1) << 5); R = (st >> 1) * 16 + swz / 64; C = (st & 1) * 32 + (swz % 64) / 2; }
__host__ __device__ __forceinline__ int perm32(int rho) { const int n = rho >> 4, i = rho & 15; return 8 * (i >> 2) + 4 * n + (i & 3); }

struct Unit { int pm, pn; };
struct Gemm { const bf16_t* A; const bf16_t* Bt; int M, N, K; };

struct StaticOrder {
    int nM, nN, nwg, G, c;
    __host__ __device__ void init(int M, int N, int G_, int c_) { nM = M / BM; nN = N / BM; nwg = nM * nN; G = G_; c = c_; }
    __host__ __device__ bool next(int i, Unit& u) const {
        const long L = (long)i * G + c; if (L >= nwg) return false;
        int wgid = (int)L; { const int q = nwg / NXCD, r = nwg % NXCD, xcd = wgid % NXCD, off = wgid / NXCD; wgid = (xcd < r ? xcd * (q + 1) : r * (q + 1) + (xcd - r) * q) + off; }
        const int nig = WGM * nN, gid = wgid / nig, fm = gid * WGM, gsz = (nM - fm) < WGM ? (nM - fm) : WGM;
        u.pm = fm + ((wgid % nig) % gsz); u.pn = (wgid % nig) / gsz; return true;
    }
    __device__ __forceinline__ void a_ready(const Unit&) const {}
    __device__ __forceinline__ void done(const Unit&) const {}
};

__device__ __forceinline__ unsigned cvt_pk_bf16(float lo, float hi) { unsigned r; asm volatile("v_cvt_pk_bf16_f32 %0, %1, %2" : "=v"(r) : "v"(lo), "v"(hi)); return r; }
typedef float f32x2 __attribute__((ext_vector_type(2)));
__device__ __forceinline__ f32x2 gelu_pk(f32x2 v) {
    const f32x2 av = __builtin_elementwise_abs(v), d = av * 0.2316418882f + 1.0f;
    f32x2 t; t.x = __builtin_amdgcn_rcpf(d.x); t.y = __builtin_amdgcn_rcpf(d.y);
    f32x2 q = t * 0.5307027145f + (-0.7265760135f); q = q * t + 0.7107068705f; q = q * t + (-0.142248368f); q = q * t + 0.127414796f; q = q * t;
    const f32x2 s = (v * v) * (-0.72134752044f);
    f32x2 e; e.x = __builtin_amdgcn_exp2f(s.x); e.y = __builtin_amdgcn_exp2f(s.y);
    const f32x2 m = v * (q * e), r = v - m;
    f32x2 o; o.x = v.x < 0.f ? m.x : r.x; o.y = v.y < 0.f ? m.y : r.y; return o;
}

template <class Epi, class Sched, bool ALIGN_EPI = false, bool SP2 = false>
__device__ __forceinline__ void gemm_phase(PG8_LAS unsigned char* lds, const Gemm g, const Sched& S, const Epi& E) {
    int tid = threadIdx.x; asm volatile("" : "+v"(tid)); const int wid = __builtin_amdgcn_readfirstlane(tid >> 6), lane = tid & 63, wr = wid >> 2, wc = wid & 3, fr = lane & 15, fq = lane >> 4;
    const int K = g.K, nt = K / BK;
    unsigned voffA[2], voffB[2];
#pragma unroll
    for (int i = 0; i < 2; ++i) { int R, C; stage_rc(tid * 16 + i * 8192, R, C); const int Rb = Epi::PERM ? ((R & ~31) + perm32(R & 31)) : R;
        voffA[i] = (unsigned)(R * K + C) * 2u; voffB[i] = (unsigned)(Rb * K + C) * 2u; }
    const size_t kstep = (size_t)(BK * 2);
    const size_t hstep = (size_t)HALF * K * 2;
    const size_t tstep = 2 * hstep;
    const unsigned ldsw = (unsigned)wid * 1024u;
    const int aoff = lds_byte(wr * 64 + fr, fq * 8), boff = lds_byte(wc * 32 + fr, fq * 8);
#define PG8_SA(b, h) (((b) * 2 + (h)) * HTB)
#define PG8_SB(b, h) ((4 + (b) * 2 + (h)) * HTB)
#define PG8_STAGE(bufoff, gbase, voff) do { _Pragma("unroll") for (int _i = 0; _i < 2; ++_i) \
        __builtin_amdgcn_global_load_lds((const unsigned*)((const char*)(gbase) + (voff)[_i]), (PG8_LAS unsigned*)(lds + (bufoff) + ldsw + _i * 8192), 16, 0, 0); } while (0)
#define PG8_LDA(dst, b, h) do { _Pragma("unroll") for (int m = 0; m < 4; ++m) _Pragma("unroll") for (int k = 0; k < 2; ++k) dst[m][k] = *(const PG8_LAS bf16x8*)(lds + PG8_SA(b, h) + aoff + m * 2048 + k * 1024); } while (0)
#define PG8_LDB(dst, b, h) do { _Pragma("unroll") for (int n = 0; n < 2; ++n) _Pragma("unroll") for (int k = 0; k < 2; ++k) dst[n][k] = *(const PG8_LAS bf16x8*)(lds + PG8_SB(b, h) + boff + n * 2048 + k * 1024); } while (0)
#define PG8_MMA(ai, bj, At, Bt) do { __builtin_amdgcn_s_setprio(1); _Pragma("unroll") for (int m = 0; m < 4; ++m) _Pragma("unroll") for (int n = 0; n < 2; ++n) _Pragma("unroll") for (int k = 0; k < 2; ++k) \
        acc[ai][bj][m][n] = __builtin_amdgcn_mfma_f32_16x16x32_bf16(Bt[n][k], At[m][k], acc[ai][bj][m][n], 0, 0, 0); __builtin_amdgcn_s_setprio(0); } while (0)
#define PG8_WAIT_V(n) asm volatile("s_waitcnt vmcnt(" #n ")" ::: "memory")
#define PG8_WAIT_L(n) asm volatile("s_waitcnt lgkmcnt(" #n ")" ::: "memory")
#define PG8_BAR __builtin_amdgcn_s_barrier()
#define PG8_SCHED __builtin_amdgcn_sched_barrier(0)
    Unit cur, nxt; int ui = 0;
    if (!S.next(0, cur)) return;
    f32x4 acc[2][2][4][2];
#pragma unroll
    for (int a = 0; a < 2; ++a)
#pragma unroll
        for (int b = 0; b < 2; ++b)
#pragma unroll
            for (int m = 0; m < 4; ++m)
#pragma unroll
                for (int n = 0; n < 2; ++n) acc[a][b][m][n] = (f32x4){0.f, 0.f, 0.f, 0.f};
    bf16x8 At[4][2], B0[2][2], B1[2][2];
    const char* cA = (const char*)g.A + (size_t)cur.pm * tstep; const char* cB = (const char*)g.Bt + (size_t)cur.pn * tstep;
    S.a_ready(cur);
    if constexpr (SP2) {
        PG8_STAGE(PG8_SB(0, 0), cB, voffB); PG8_STAGE(PG8_SB(0, 1), cB + hstep, voffB); PG8_STAGE(PG8_SA(0, 0), cA, voffA); PG8_STAGE(PG8_SA(0, 1), cA + hstep, voffA);
        if (wr == 1) PG8_BAR;
        PG8_WAIT_V(2); PG8_BAR;
        PG8_STAGE(PG8_SB(1, 0), cB + kstep, voffB); PG8_STAGE(PG8_SA(1, 0), cA + kstep, voffA); PG8_STAGE(PG8_SB(1, 1), cB + hstep + kstep, voffB);
        PG8_WAIT_V(6); PG8_BAR;
    } else {
        PG8_STAGE(PG8_SB(0, 0), cB, voffB); PG8_STAGE(PG8_SA(0, 0), cA, voffA); PG8_STAGE(PG8_SB(0, 1), cB + hstep, voffB); PG8_STAGE(PG8_SA(0, 1), cA + hstep, voffA);
        if (wr == 1) PG8_BAR;
        PG8_WAIT_V(4); PG8_BAR;
        PG8_STAGE(PG8_SB(1, 0), cB + kstep, voffB); PG8_STAGE(PG8_SA(1, 0), cA + kstep, voffA); PG8_STAGE(PG8_SB(1, 1), cB + hstep + kstep, voffB);
        PG8_WAIT_V(6); PG8_BAR;
    }
    for (;;) {
        const bool has_next = S.next(ui + 1, nxt);
        const char* nA = has_next ? (const char*)g.A + (size_t)nxt.pm * tstep : cA; const char* nB = has_next ? (const char*)g.Bt + (size_t)nxt.pn * tstep : cB;
        for (int t = 0; t < nt; t += 2) {
            const bool last = (t == nt - 2);
            const char* a1 = cA + (size_t)(t + 1) * kstep;
            const char* a2 = last ? nA : cA + (size_t)(t + 2) * kstep; const char* b2 = last ? nB : cB + (size_t)(t + 2) * kstep;
            const char* a3 = a2 + kstep; const char* b3 = b2 + kstep;
            if (last && has_next) S.a_ready(nxt);
            if constexpr (SP2) {
            PG8_LDB(B0, 0, 0); PG8_LDB(B1, 0, 1); PG8_SCHED; PG8_LDA(At, 0, 0); PG8_STAGE(PG8_SA(1, 1), a1 + hstep, voffA);
            PG8_WAIT_V(8); PG8_WAIT_L(0); PG8_BAR; PG8_MMA(0, 0, At, B0); PG8_MMA(0, 1, At, B1); PG8_BAR; PG8_SCHED;
            PG8_LDA(At, 0, 1); PG8_STAGE(PG8_SB(0, 0), b2, voffB); PG8_STAGE(PG8_SB(0, 1), b2 + hstep, voffB); PG8_STAGE(PG8_SA(0, 0), a2, voffA);
            PG8_WAIT_V(8); PG8_WAIT_L(0); PG8_BAR; PG8_MMA(1, 0, At, B0); PG8_MMA(1, 1, At, B1); PG8_BAR; PG8_SCHED;
            PG8_LDB(B0, 1, 0); PG8_LDB(B1, 1, 1); PG8_SCHED; PG8_LDA(At, 1, 0); PG8_STAGE(PG8_SA(0, 1), a2 + hstep, voffA);
            PG8_WAIT_V(8); PG8_WAIT_L(0); PG8_BAR; PG8_MMA(0, 0, At, B0); PG8_MMA(0, 1, At, B1); PG8_BAR; PG8_SCHED;
            PG8_LDA(At, 1, 1); PG8_STAGE(PG8_SB(1, 0), b3, voffB); PG8_STAGE(PG8_SB(1, 1), b3 + hstep, voffB); PG8_STAGE(PG8_SA(1, 0), a3, voffA);
            PG8_WAIT_V(8); PG8_WAIT_L(0); PG8_BAR; PG8_MMA(1, 0, At, B0); PG8_MMA(1, 1, At, B1); PG8_BAR; PG8_SCHED;
            } else {
            PG8_LDB(B0, 0, 0); PG8_SCHED; PG8_LDA(At, 0, 0); PG8_STAGE(PG8_SA(1, 1), a1 + hstep, voffA);
            PG8_WAIT_L(8); PG8_BAR; PG8_WAIT_L(0); PG8_MMA(0, 0, At, B0); PG8_BAR; PG8_SCHED;
            PG8_LDB(B1, 0, 1); PG8_STAGE(PG8_SB(0, 0), b2, voffB);
            PG8_BAR; PG8_WAIT_L(0); PG8_MMA(0, 1, At, B1); PG8_BAR;
            PG8_LDA(At, 0, 1); PG8_STAGE(PG8_SA(0, 0), a2, voffA);
            PG8_BAR; PG8_WAIT_L(0); PG8_MMA(1, 0, At, B0); PG8_BAR; PG8_SCHED;
            PG8_STAGE(PG8_SB(0, 1), b2 + hstep, voffB);
            PG8_WAIT_V(6); PG8_BAR; PG8_MMA(1, 1, At, B1); PG8_BAR;
            PG8_LDB(B0, 1, 0); PG8_SCHED; PG8_LDA(At, 1, 0); PG8_STAGE(PG8_SA(0, 1), a2 + hstep, voffA);
            PG8_WAIT_L(8); PG8_BAR; PG8_WAIT_L(0); PG8_MMA(0, 0, At, B0); PG8_BAR; PG8_SCHED;
            PG8_LDB(B1, 1, 1); PG8_STAGE(PG8_SB(1, 0), b3, voffB);
            PG8_BAR; PG8_WAIT_L(0); PG8_MMA(0, 1, At, B1); PG8_BAR;
            PG8_LDA(At, 1, 1); PG8_STAGE(PG8_SA(1, 0), a3, voffA);
            PG8_BAR; PG8_WAIT_L(0); PG8_MMA(1, 0, At, B0); PG8_BAR; PG8_SCHED;
            PG8_STAGE(PG8_SB(1, 1), b3 + hstep, voffB);
            PG8_WAIT_V(6); PG8_BAR; PG8_MMA(1, 1, At, B1); PG8_BAR;
            }
        }
        if constexpr (ALIGN_EPI) { if (wr == 0) PG8_BAR; }
        if constexpr (!Epi::AFTER_DRAIN) { E(acc, cur, wr, wc, fr, fq); S.done(cur); }
        if (!has_next) break;
#pragma unroll
        for (int a = 0; a < 2; ++a)
#pragma unroll
            for (int b = 0; b < 2; ++b)
#pragma unroll
                for (int m = 0; m < 4; ++m)
#pragma unroll
                    for (int n = 0; n < 2; ++n) acc[a][b][m][n] = (f32x4){0.f, 0.f, 0.f, 0.f};
        cur = nxt; cA = nA; cB = nB; ++ui;
        if constexpr (ALIGN_EPI) { if (wr == 1) PG8_BAR; }
    }
    PG8_WAIT_V(0);
    if constexpr (!ALIGN_EPI) { if (wr == 0) PG8_BAR; }
    PG8_BAR;
    if constexpr (Epi::AFTER_DRAIN) { E.fused(acc, cur, wr, wc, fr, fq, lds, wid, lane); S.done(cur); }
#undef PG8_SA
#undef PG8_SB
#undef PG8_STAGE
#undef PG8_LDA
#undef PG8_LDB
#undef PG8_MMA
#undef PG8_WAIT_V
#undef PG8_WAIT_L
#undef PG8_BAR
#undef PG8_SCHED
}
}
namespace mk {
using pg8::bf16_t; using pg8::f32x4; using pg8::u32x4; using pg8::Unit; using pg8::f32x2;
typedef short bf16x8 __attribute__((ext_vector_type(8)));
typedef short s16x4 __attribute__((ext_vector_type(4)));
typedef float f32x16 __attribute__((ext_vector_type(16)));
#define LAS __attribute__((address_space(3)))

constexpr int DM = 1024, SEQ = 2048, NBATCH = 24, DEPTH = 4;
constexpr int GSEQ = 8, T = GSEQ * SEQ, NG = NBATCH / GSEQ;
constexpr int NIN = 5632, NUP = 5632, DFF = 2816;
constexpr float LN_EPS = 1e-5f, RMS_EPS = 1e-6f;
constexpr float ALPHA = 1.681792830507429f;
constexpr float QSCALE = 0.07216878364870322f * 1.4426950408889634f;
constexpr float RKSCALE = 0.08838834764831845f;
enum { I_XP = 0, I_XS, I_CP, I_CS, I_WADA, I_BADA, I_WIN, I_RDF, I_RDB, I_GN, I_WRETO, I_QNG, I_KVNG, I_WUQ, I_WUK, I_WUV, I_WMLAO, I_WOUT,
       I_LN1G, I_LN1B, I_WUP, I_CONVW, I_CONVB, I_WDOWN, I_LN2G, I_LN2B, N_INPUTS };
constexpr size_t MiB = 1u << 20;
constexpr size_t WS_ADA = 1 * MiB, WS_COSR = 4 * MiB, WS_SINR = 4 * MiB + 512 * 1024, WS_COSM = 5 * MiB, WS_SINM = 5 * MiB + 256 * 1024;
constexpr size_t WS_SSQQ = 5 * MiB + 512 * 1024, WS_SSQKV = 5 * MiB + 768 * 1024;
constexpr size_t WS_W = 6 * MiB;
constexpr size_t WO_IN = 0, WO_RETO = WO_IN + (size_t)NIN * 1024 * 2, WO_UQ = WO_RETO + 1024 * 1024 * 2, WO_UKV = WO_UQ + 1536 * 256 * 2,
                 WO_MLAO = WO_UKV + 2048 * 128 * 2, WO_OUT = WO_MLAO + 1024 * 1024 * 2, WO_UP = WO_OUT + 1024 * 1024 * 2, WO_DOWN = WO_UP + (size_t)NUP * 1024 * 2,
                 W_LAYER = WO_DOWN + (size_t)1024 * DFF * 2;
static_assert(W_LAYER * 4 <= 139 * MiB, "weights");
constexpr size_t WS_H = 145 * MiB, WS_QR = 177 * MiB, WS_KR = 193 * MiB, WS_VR = 209 * MiB, WS_GR = 241 * MiB, WS_DQ = 273 * MiB, WS_DKV = 281 * MiB, WS_KROPE = 285 * MiB,
                 WS_GA = 288 * MiB, WS_GB = 320 * MiB, WS_QN = 352 * MiB, WS_QRP = 384 * MiB, WS_KN = 400 * MiB, WS_VM = 432 * MiB, WS_RO = 464 * MiB, WS_END = 496 * MiB;
constexpr size_t WS_AO = WS_QN, WS_MG = WS_VR, WS_AB = 177 * MiB, WS_U = 353 * MiB;
static_assert(WS_AB + (size_t)T * NUP * 2 <= WS_U && WS_U + (size_t)T * DFF * 2 <= WS_END, "ffn overlay");
constexpr int LDS_BYTES = 147456;

__device__ __forceinline__ unsigned cvtpk(float lo, float hi) { unsigned r; asm volatile("v_cvt_pk_bf16_f32 %0, %1, %2" : "=v"(r) : "v"(lo), "v"(hi)); return r; }
__device__ __forceinline__ float bf2f(unsigned short b) { return __uint_as_float((unsigned)b << 16); }
__device__ __forceinline__ float bflo(unsigned w) { return __uint_as_float(w << 16); }
__device__ __forceinline__ float bfhi(unsigned w) { return __uint_as_float(w & 0xffff0000u); }
__device__ __forceinline__ float sigmoidf_(float x) { return 1.0f / (1.0f + __expf(-x)); }
__device__ __forceinline__ u32x4 pack8(const f32x4 a, const f32x4 b) { u32x4 w; w.x = cvtpk(a[0], a[1]); w.y = cvtpk(a[2], a[3]); w.z = cvtpk(b[0], b[1]); w.w = cvtpk(b[2], b[3]); return w; }
__device__ __forceinline__ void unpack8(const u32x4 w, f32x4& a, f32x4& b) { a = (f32x4){bflo(w.x), bfhi(w.x), bflo(w.y), bfhi(w.y)}; b = (f32x4){bflo(w.z), bfhi(w.z), bflo(w.w), bfhi(w.w)}; }
__device__ __forceinline__ float wave_sum(float v) {
#pragma unroll
    for (int o = 1; o < 64; o <<= 1) v += __shfl_xor(v, o);
    return v;
}
__device__ __forceinline__ void rope8(f32x4& v0, f32x4& v1, const f32x4 c, const f32x4 s) {
    float a, b;
    a = v0[0]; b = v0[1]; v0[0] = a * c[0] - b * s[0]; v0[1] = b * c[0] + a * s[0];
    a = v0[2]; b = v0[3]; v0[2] = a * c[1] - b * s[1]; v0[3] = b * c[1] + a * s[1];
    a = v1[0]; b = v1[1]; v1[0] = a * c[2] - b * s[2]; v1[1] = b * c[2] + a * s[2];
    a = v1[2]; b = v1[3]; v1[2] = a * c[3] - b * s[3]; v1[3] = b * c[3] + a * s[3];
}

struct EpiCommon { static constexpr bool PERM = true, AFTER_DRAIN = false; };

struct EpiIn : EpiCommon {
    unsigned char* ws;
    __device__ __forceinline__ void operator()(const f32x4 (&acc)[2][2][4][2], const Unit& u, int wr, int wc, int fr, int fq) const {
        const int pn = u.pn, cw = wc * 32 + 8 * fq;
        const float* cosR = (const float*)(ws + WS_COSR); const float* sinR = (const float*)(ws + WS_SINR);
        const float* cosM = (const float*)(ws + WS_COSM); const float* sinM = (const float*)(ws + WS_SINM);
#pragma unroll
        for (int ai = 0; ai < 2; ++ai)
#pragma unroll
            for (int m = 0; m < 4; ++m) {
                const int r = u.pm * 256 + ai * 128 + wr * 64 + m * 16 + fr, pos = r & (SEQ - 1);
                if (pn < 4) {
                    bf16_t* dst = (bf16_t*)(ws + (pn < 2 ? WS_QR : WS_KR)) + (size_t)r * 512 + (pn & 1) * 256 + cw;
                    const float sc = pn < 2 ? 1.0f : RKSCALE;
                    const f32x4 c = *(const f32x4*)(cosR + pos * 64 + (cw >> 1)), s = *(const f32x4*)(sinR + pos * 64 + (cw >> 1));
#pragma unroll
                    for (int bj = 0; bj < 2; ++bj) { f32x4 v0 = acc[ai][bj][m][0], v1 = acc[ai][bj][m][1]; rope8(v0, v1, c, s); v0 = v0 * sc; v1 = v1 * sc; *(u32x4*)(dst + bj * 128) = pack8(v0, v1); }
                } else if (pn < 8) {
                    bf16_t* dst = (bf16_t*)(ws + WS_VR) + (size_t)r * 1024 + (pn - 4) * 256 + cw;
#pragma unroll
                    for (int bj = 0; bj < 2; ++bj) *(u32x4*)(dst + bj * 128) = pack8(acc[ai][bj][m][0], acc[ai][bj][m][1]);
                } else if (pn < 12) {
                    bf16_t* dst = (bf16_t*)(ws + WS_GR) + (size_t)r * 1024 + (pn - 8) * 256 + cw;
#pragma unroll
                    for (int bj = 0; bj < 2; ++bj) { f32x4 v0 = acc[ai][bj][m][0], v1 = acc[ai][bj][m][1];
#pragma unroll
                        for (int e = 0; e < 4; ++e) { v0[e] = v0[e] * sigmoidf_(v0[e]); v1[e] = v1[e] * sigmoidf_(v1[e]); }
                        *(u32x4*)(dst + bj * 128) = pack8(v0, v1); }
                } else if (pn == 12) {
                    bf16_t* dst = (bf16_t*)(ws + WS_DQ) + (size_t)r * 256 + cw; float ss = 0.f;
#pragma unroll
                    for (int bj = 0; bj < 2; ++bj) { const f32x4 v0 = acc[ai][bj][m][0], v1 = acc[ai][bj][m][1];
                        ss += (v0[0] * v0[0] + v0[1] * v0[1]) + (v0[2] * v0[2] + v0[3] * v0[3]) + (v1[0] * v1[0] + v1[1] * v1[1]) + (v1[2] * v1[2] + v1[3] * v1[3]);
                        *(u32x4*)(dst + bj * 128) = pack8(v0, v1); }
                    ss += __shfl_xor(ss, 16); ss += __shfl_xor(ss, 32);
                    if (fq == 0) ((float*)(ws + WS_SSQQ))[(size_t)r * 4 + wc] = ss;
                } else if (pn == 13) {
                    { const f32x4 v0 = acc[ai][0][m][0], v1 = acc[ai][0][m][1];
                      float ss = (v0[0] * v0[0] + v0[1] * v0[1]) + (v0[2] * v0[2] + v0[3] * v0[3]) + (v1[0] * v1[0] + v1[1] * v1[1]) + (v1[2] * v1[2] + v1[3] * v1[3]);
                      *(u32x4*)((bf16_t*)(ws + WS_DKV) + (size_t)r * 128 + cw) = pack8(v0, v1);
                      ss += __shfl_xor(ss, 16); ss += __shfl_xor(ss, 32);
                      if (fq == 0) ((float*)(ws + WS_SSQKV))[(size_t)r * 4 + wc] = ss; }
                    if (wc < 2) { f32x4 v0 = acc[ai][1][m][0], v1 = acc[ai][1][m][1];
                      const f32x4 c = *(const f32x4*)(cosM + pos * 32 + (cw >> 1)), s = *(const f32x4*)(sinM + pos * 32 + (cw >> 1));
                      rope8(v0, v1, c, s); *(u32x4*)((bf16_t*)(ws + WS_KROPE) + (size_t)r * 64 + cw) = pack8(v0, v1); }
                } else {
                    bf16_t* dst = (bf16_t*)(ws + (pn < 18 ? WS_GA : WS_GB)) + (size_t)r * 1024 + ((pn - 14) & 3) * 256 + cw;
#pragma unroll
                    for (int bj = 0; bj < 2; ++bj) { f32x4 v0 = acc[ai][bj][m][0], v1 = acc[ai][bj][m][1];
#pragma unroll
                        for (int e = 0; e < 4; ++e) { v0[e] = sigmoidf_(v0[e]); v1[e] = sigmoidf_(v1[e]); }
                        *(u32x4*)(dst + bj * 128) = pack8(v0, v1); }
                }
                asm volatile("" ::: "memory");
            }
    }
};
struct EpiUQ : EpiCommon {
    unsigned char* ws;
    __device__ __forceinline__ void operator()(const f32x4 (&acc)[2][2][4][2], const Unit& u, int wr, int wc, int fr, int fq) const {
        const int pn = u.pn, cw = wc * 32 + 8 * fq;
        const float* cosM = (const float*)(ws + WS_COSM); const float* sinM = (const float*)(ws + WS_SINM);
#pragma unroll
        for (int ai = 0; ai < 2; ++ai)
#pragma unroll
            for (int m = 0; m < 4; ++m) {
                const int r = u.pm * 256 + ai * 128 + wr * 64 + m * 16 + fr, pos = r & (SEQ - 1);
                const f32x4 q4 = *(const f32x4*)((const float*)(ws + WS_SSQQ) + (size_t)r * 4);
                const float rs = rsqrtf(((q4[0] + q4[1]) + (q4[2] + q4[3])) * (1.0f / 256.0f) + RMS_EPS) * QSCALE;
                if (pn < 4) {
                    bf16_t* dst = (bf16_t*)(ws + WS_QN) + (size_t)r * 1024 + pn * 256 + cw;
#pragma unroll
                    for (int bj = 0; bj < 2; ++bj) *(u32x4*)(dst + bj * 128) = pack8(acc[ai][bj][m][0] * rs, acc[ai][bj][m][1] * rs);
                } else {
                    bf16_t* dst = (bf16_t*)(ws + WS_QRP) + (size_t)r * 512 + (pn - 4) * 256 + cw;
                    const int i0 = ((wc & 1) * 32 + 8 * fq) >> 1;
                    const f32x4 c = *(const f32x4*)(cosM + pos * 32 + i0), s = *(const f32x4*)(sinM + pos * 32 + i0);
#pragma unroll
                    for (int bj = 0; bj < 2; ++bj) { f32x4 v0 = acc[ai][bj][m][0], v1 = acc[ai][bj][m][1]; rope8(v0, v1, c, s); *(u32x4*)(dst + bj * 128) = pack8(v0 * rs, v1 * rs); }
                }
                asm volatile("" ::: "memory");
            }
    }
};
struct EpiUKV : EpiCommon {
    unsigned char* ws;
    __device__ __forceinline__ void operator()(const f32x4 (&acc)[2][2][4][2], const Unit& u, int wr, int wc, int fr, int fq) const {
        const int pn = u.pn, cw = wc * 32 + 8 * fq;
#pragma unroll
        for (int ai = 0; ai < 2; ++ai)
#pragma unroll
            for (int m = 0; m < 4; ++m) {
                const int r = u.pm * 256 + ai * 128 + wr * 64 + m * 16 + fr;
                const f32x4 q4 = *(const f32x4*)((const float*)(ws + WS_SSQKV) + (size_t)r * 4);
                const float rs = rsqrtf(((q4[0] + q4[1]) + (q4[2] + q4[3])) * (1.0f / 128.0f) + RMS_EPS);
                bf16_t* dst = (bf16_t*)(ws + (pn < 4 ? WS_KN : WS_VM)) + (size_t)r * 1024 + (pn & 3) * 256 + cw;
#pragma unroll
                for (int bj = 0; bj < 2; ++bj) *(u32x4*)(dst + bj * 128) = pack8(acc[ai][bj][m][0] * rs, acc[ai][bj][m][1] * rs);
                asm volatile("" ::: "memory");
            }
    }
};
template <bool FIRST> struct EpiMerge : EpiCommon {
    unsigned char* ws;
    __device__ __forceinline__ void operator()(const f32x4 (&acc)[2][2][4][2], const Unit& u, int wr, int wc, int fr, int fq) const {
        const int cw = u.pn * 256 + wc * 32 + 8 * fq;
#pragma unroll
        for (int ai = 0; ai < 2; ++ai)
#pragma unroll
            for (int m = 0; m < 4; ++m) {
                const size_t off = (size_t)(u.pm * 256 + ai * 128 + wr * 64 + m * 16 + fr) * 1024 + cw;
#pragma unroll
                for (int bj = 0; bj < 2; ++bj) {
                    f32x4 g0, g1; unpack8(*(const u32x4*)((const bf16_t*)(ws + (FIRST ? WS_GA : WS_GB)) + off + bj * 128), g0, g1);
                    f32x4 v0 = acc[ai][bj][m][0] * g0, v1 = acc[ai][bj][m][1] * g1;
                    bf16_t* dst = (bf16_t*)(ws + WS_MG) + off + bj * 128;
                    if (!FIRST) { f32x4 p0, p1; unpack8(*(const u32x4*)dst, p0, p1); v0 += p0; v1 += p1; }
                    *(u32x4*)dst = pack8(v0, v1);
                }
                asm volatile("" ::: "memory");
            }
    }
};
struct EpiRes : EpiCommon {
    float* x; const float* gate;
    __device__ __forceinline__ void operator()(const f32x4 (&acc)[2][2][4][2], const Unit& u, int wr, int wc, int fr, int fq) const {
        const int cw = u.pn * 256 + wc * 32 + 8 * fq;
        const float* gp = gate + (size_t)(u.pm >> 3) * 6144 + cw;
        f32x4 gg[2][2];
#pragma unroll
        for (int bj = 0; bj < 2; ++bj)
#pragma unroll
            for (int n = 0; n < 2; ++n) gg[bj][n] = *(const f32x4*)(gp + bj * 128 + 4 * n) + 1.0f;
#pragma unroll
        for (int ai = 0; ai < 2; ++ai)
#pragma unroll
            for (int m = 0; m < 4; ++m) {
                float* xp = x + (size_t)(u.pm * 256 + ai * 128 + wr * 64 + m * 16 + fr) * 1024 + cw;
#pragma unroll
                for (int bj = 0; bj < 2; ++bj)
#pragma unroll
                    for (int n = 0; n < 2; ++n) { f32x4* q = (f32x4*)(xp + bj * 128 + 4 * n); *q = *q * ALPHA + gg[bj][n] * acc[ai][bj][m][n]; }
                asm volatile("" ::: "memory");
            }
    }
};
struct EpiUp : EpiCommon {
    unsigned char* ws;
    __device__ __forceinline__ void operator()(const f32x4 (&acc)[2][2][4][2], const Unit& u, int wr, int wc, int fr, int fq) const {
        const int cw = u.pn * 256 + wc * 32 + 8 * fq;
#pragma unroll
        for (int ai = 0; ai < 2; ++ai)
#pragma unroll
            for (int m = 0; m < 4; ++m) {
                bf16_t* dst = (bf16_t*)(ws + WS_AB) + (size_t)(u.pm * 256 + ai * 128 + wr * 64 + m * 16 + fr) * NUP + cw;
#pragma unroll
                for (int bj = 0; bj < 2; ++bj) *(u32x4*)(dst + bj * 128) = pack8(acc[ai][bj][m][0], acc[ai][bj][m][1]);
            }
    }
};
#define SBAR() __builtin_amdgcn_sched_barrier(0)
__device__ __forceinline__ int crow(int r, int hi) { return (r & 3) + 8 * (r >> 2) + 4 * hi; }
__device__ __forceinline__ int v_st(int k, int c) { const int kk = (k & ~0xC) | ((k & 4) << 1) | ((k & 8) >> 1); return ((kk >> 3) * 4 + (c >> 5)) * 512 + ((kk & 7) * 32 + (c & 31)) * 2; }
__device__ __forceinline__ int v_rd_base(int lane) { return ((lane & 3) << 3) | (((lane >> 2) & 3) << 6) | (((lane >> 4) & 1) << 5) | (((lane >> 5) & 1) << 8); }
constexpr int v_rd_off(int d0, int ks, int half) { return d0 * 512 + ks * 4096 + half * 2048; }
template <int OFF> __device__ __forceinline__ s16x4 tr_read(int vb) {
    s16x4 r; asm volatile("ds_read_b64_tr_b16 %0, %1 offset:%2" : "=&v"(r) : "v"(vb), "i"(OFF) : "memory"); return r;
}
template <int D0> __device__ __forceinline__ void pv_one(f32x16& od, int vb, bf16x8 pa0, bf16x8 pa1, bf16x8 pa2, bf16x8 pa3) {
    const s16x4 l0 = tr_read<v_rd_off(D0, 0, 0)>(vb), h0 = tr_read<v_rd_off(D0, 0, 1)>(vb), l1 = tr_read<v_rd_off(D0, 1, 0)>(vb), h1 = tr_read<v_rd_off(D0, 1, 1)>(vb);
    const s16x4 l2 = tr_read<v_rd_off(D0, 2, 0)>(vb), h2 = tr_read<v_rd_off(D0, 2, 1)>(vb), l3 = tr_read<v_rd_off(D0, 3, 0)>(vb), h3 = tr_read<v_rd_off(D0, 3, 1)>(vb);
    asm volatile("s_waitcnt lgkmcnt(0)" ::: "memory"); SBAR();
#define PK(L, H) (bf16x8){L[0], L[1], L[2], L[3], H[0], H[1], H[2], H[3]}
    od = __builtin_amdgcn_mfma_f32_32x32x16_bf16(pa0, PK(l0, h0), od, 0, 0, 0);
    od = __builtin_amdgcn_mfma_f32_32x32x16_bf16(pa1, PK(l1, h1), od, 0, 0, 0);
    od = __builtin_amdgcn_mfma_f32_32x32x16_bf16(pa2, PK(l2, h2), od, 0, 0, 0);
    od = __builtin_amdgcn_mfma_f32_32x32x16_bf16(pa3, PK(l3, h3), od, 0, 0, 0);
#undef PK
}
__device__ __forceinline__ void pv_d0(f32x16* o, int vb, bf16x8 pa0, bf16x8 pa1, bf16x8 pa2, bf16x8 pa3) {
    pv_one<0>(o[0], vb, pa0, pa1, pa2, pa3); pv_one<1>(o[1], vb, pa0, pa1, pa2, pa3); pv_one<2>(o[2], vb, pa0, pa1, pa2, pa3); pv_one<3>(o[3], vb, pa0, pa1, pa2, pa3);
}
__device__ __forceinline__ void pack_p(const f32x16& p0, const f32x16& p1, bf16x8& pa0, bf16x8& pa1, bf16x8& pa2, bf16x8& pa3) {
#define PK4(P, BASE, OUT) do { unsigned a0 = cvtpk(P[BASE + 0], P[BASE + 1]), a1 = cvtpk(P[BASE + 2], P[BASE + 3]);   \
    unsigned b0 = cvtpk(P[BASE + 4], P[BASE + 5]), b1 = cvtpk(P[BASE + 6], P[BASE + 7]);                              \
    auto r0 = __builtin_amdgcn_permlane32_swap(a0, b0, false, false); auto r1 = __builtin_amdgcn_permlane32_swap(a1, b1, false, false); \
    u32x4 w = {r0[0], r1[0], r0[1], r1[1]}; OUT = *reinterpret_cast<bf16x8*>(&w); } while (0)
    PK4(p0, 0, pa0); PK4(p0, 8, pa1); PK4(p1, 0, pa2); PK4(p1, 8, pa3);
#undef PK4
}
constexpr float FA_THR = 11.5f;
__device__ __forceinline__ void partialSM(f32x16& p0, f32x16& p1, float& m_reg, float& alpha) {
    float pmax = p0[0];
#pragma unroll
    for (int r = 1; r < 16; ++r) pmax = fmaxf(pmax, p0[r]);
#pragma unroll
    for (int r = 0; r < 16; ++r) pmax = fmaxf(pmax, p1[r]);
    { auto rr = __builtin_amdgcn_permlane32_swap(__float_as_uint(pmax), __float_as_uint(pmax), false, false);
      pmax = fmaxf(__uint_as_float(rr[0]), __uint_as_float(rr[1])); }
    float mn;
    if (__builtin_expect(__all(pmax - m_reg <= FA_THR), 1)) { mn = m_reg; alpha = 1.f; }
    else { mn = fmaxf(m_reg, pmax); alpha = __builtin_amdgcn_exp2f(m_reg - mn); m_reg = mn; }
#pragma unroll
    for (int r = 0; r < 16; ++r) p0[r] = p0[r] - mn;
#pragma unroll
    for (int r = 0; r < 16; ++r) p1[r] = p1[r] - mn;
#pragma unroll
    for (int r = 0; r < 16; ++r) p0[r] = __builtin_amdgcn_exp2f(p0[r]);
}
__device__ __forceinline__ void finishSM(f32x16& p0, f32x16& p1, float alpha, float& l_reg, bf16x8& pa0, bf16x8& pa1, bf16x8& pa2, bf16x8& pa3) {
#pragma unroll
    for (int r = 0; r < 16; ++r) p1[r] = __builtin_amdgcn_exp2f(p1[r]);
    float ps = 0;
#pragma unroll
    for (int r = 0; r < 16; ++r) ps += p0[r];
#pragma unroll
    for (int r = 0; r < 16; ++r) ps += p1[r];
    { auto rr = __builtin_amdgcn_permlane32_swap(__float_as_uint(ps), __float_as_uint(ps), false, false);
      ps = __uint_as_float(rr[0]) + __uint_as_float(rr[1]); }
    l_reg = l_reg * alpha + ps;
    pack_p(p0, p1, pa0, pa1, pa2, pa3);
}
template <int HALF> __device__ __forceinline__ void decay_half(f32x16& p, float dbase, float lf2, float nlb2) {
#pragma unroll
    for (int r = 0; r < 16; ++r) { const float d = dbase - (float)((r & 3) + 8 * (r >> 2) + 32 * HALF); const float e = d * (d >= 0.f ? lf2 : nlb2); p[r] *= __builtin_amdgcn_exp2f(e); }
}

struct FaArgs {
    const bf16_t* Q1; const bf16_t* Q2; const bf16_t* K1; const bf16_t* K2; const bf16_t* V; bf16_t* O;
    int q0; float lf2, nlb2;
};
template <int MODE> __device__ __forceinline__ void flash_unit(const FaArgs& A, char* lds) {
    constexpr int ND0 = MODE == 0 ? 12 : 8, KROW = ND0 * 32, SHM_V = 64 * 256, SHM_K = 64 * KROW, SDEPTH = 1, NLD = MODE == 0 ? 5 : 4;
    constexpr int LDQ1 = MODE == 0 ? 1024 : 512, LDQ2 = 512, LDK1 = MODE == 0 ? 1024 : 512, LDK2 = 64, LDV = 1024, LDO = 1024;
    int tid = threadIdx.x; asm volatile("" : "+v"(tid)); const int wid = tid >> 6, lane = tid & 63, r32 = lane & 31, hi = lane >> 5;
    char* V_lds = lds; char* K_lds = lds + 2 * SHM_V;
    float* wsf = (float*)(lds + 2 * SHM_V + 2 * SHM_K) + wid * 64; float* li_l = wsf; float* al_l = wsf + 32;
#define KSWZ(row, colB) ((row) * KROW + ((colB) ^ (((row) & 7) << 4)))
    float m_reg = -1e30f, l_reg = 0.f; f32x16 o[4] = {}; bf16x8 qr[8];
    char* qs = lds + 2 * SHM_V + 2 * SHM_K + 2048 + tid * 16;
    {
        const long qrow = A.q0 + wid * 32 + r32;
        const bf16_t* Qw = A.Q1 + qrow * LDQ1 + hi * 8;
#pragma unroll
        for (int d0 = 0; d0 < 8; ++d0) qr[d0] = *reinterpret_cast<const bf16x8*>(Qw + d0 * 16);
        if constexpr (MODE == 0) {
            const bf16_t* Qw2 = A.Q2 + qrow * LDQ2 + hi * 8;
#pragma unroll
            for (int d0 = 0; d0 < 4; ++d0) *reinterpret_cast<bf16x8*>(qs + d0 * 8192) = *reinterpret_cast<const bf16x8*>(Qw2 + d0 * 16);
        }
    }
    const int sr = tid >> 4, sc = (tid & 15) * 8, vst0 = v_st(sr, sc), vst1 = v_st(32 + sr, sc);
    const int sr2 = tid >> 3, sc2 = (tid & 7) * 8;
    const int vb0 = (int)(uintptr_t)V_lds + v_rd_base(lane);
    struct { bf16x8 vs0, vs1, ks0, ks1, kr; } st_[SDEPTH];
#define SLOAD(i, k0) do { st_[i].vs0 = *(const bf16x8*)(A.V + (long)((k0) + sr) * LDV + sc); st_[i].vs1 = *(const bf16x8*)(A.V + (long)((k0) + 32 + sr) * LDV + sc); \
    st_[i].ks0 = *(const bf16x8*)(A.K1 + (long)((k0) + sr) * LDK1 + sc); st_[i].ks1 = *(const bf16x8*)(A.K1 + (long)((k0) + 32 + sr) * LDK1 + sc); \
    if constexpr (MODE == 0) st_[i].kr = *(const bf16x8*)(A.K2 + (long)((k0) + sr2) * LDK2 + sc2); } while (0)
#define SWRITE(b, i) do { *(bf16x8*)(V_lds + (b) * SHM_V + vst0) = st_[i].vs0; *(bf16x8*)(V_lds + (b) * SHM_V + vst1) = st_[i].vs1; \
    *(bf16x8*)(K_lds + (b) * SHM_K + KSWZ(sr, sc * 2)) = st_[i].ks0; *(bf16x8*)(K_lds + (b) * SHM_K + KSWZ(32 + sr, sc * 2)) = st_[i].ks1; \
    if constexpr (MODE == 0) *(bf16x8*)(K_lds + (b) * SHM_K + KSWZ(sr2, 256 + sc2 * 2)) = st_[i].kr; } while (0)
#define SWAIT() do { if constexpr (SDEPTH == 2) { if constexpr (NLD == 5) asm volatile("s_waitcnt vmcnt(5)" ::: "memory"); else asm volatile("s_waitcnt vmcnt(4)" ::: "memory"); } \
    else asm volatile("s_waitcnt vmcnt(0)" ::: "memory"); } while (0)
#define RESC(a) do { if constexpr (MODE == 0) { if (__any((a) < 1.f)) { if (hi == 0) al_l[r32] = (a); asm volatile("s_waitcnt lgkmcnt(0)" ::: "memory"); \
    _Pragma("unroll") for (int d = 0; d < 4; ++d) _Pragma("unroll") for (int r = 0; r < 16; ++r) o[d][r] *= al_l[crow(r, hi)]; } } } while (0)
#define QKT(P0, P1, KB) do { P0 = f32x16{}; P1 = f32x16{}; \
    _Pragma("unroll") for (int d0 = 0; d0 < 8; ++d0) { const int cb = (d0 * 16 + hi * 8) * 2; \
      const bf16x8 b0 = *reinterpret_cast<const bf16x8*>((KB) + KSWZ(r32, cb)); const bf16x8 b1 = *reinterpret_cast<const bf16x8*>((KB) + KSWZ(32 + r32, cb)); \
      P0 = __builtin_amdgcn_mfma_f32_32x32x16_bf16(b0, qr[d0], P0, 0, 0, 0); P1 = __builtin_amdgcn_mfma_f32_32x32x16_bf16(b1, qr[d0], P1, 0, 0, 0); } \
    if constexpr (MODE == 0) { _Pragma("unroll") for (int d0 = 0; d0 < 4; ++d0) { const int cb = ((8 + d0) * 16 + hi * 8) * 2; const bf16x8 qx = *reinterpret_cast<const bf16x8*>(qs + d0 * 8192); \
      const bf16x8 b0 = *reinterpret_cast<const bf16x8*>((KB) + KSWZ(r32, cb)); const bf16x8 b1 = *reinterpret_cast<const bf16x8*>((KB) + KSWZ(32 + r32, cb)); \
      P0 = __builtin_amdgcn_mfma_f32_32x32x16_bf16(b0, qx, P0, 0, 0, 0); P1 = __builtin_amdgcn_mfma_f32_32x32x16_bf16(b1, qx, P1, 0, 0, 0); } } } while (0)
    const float tq = (float)(A.q0 + wid * 32 + r32 - 4 * hi);
#define PARTIAL(P0, P1, AL, J) do { if constexpr (MODE == 0) partialSM(P0, P1, m_reg, AL); else decay_half<0>(P0, tq - (float)((J) * 64), A.lf2, A.nlb2); } while (0)
#define FINISH(P0, P1, AL, J) do { if constexpr (MODE == 0) finishSM(P0, P1, AL, l_reg, pa0, pa1, pa2, pa3); else { decay_half<1>(P1, tq - (float)((J) * 64), A.lf2, A.nlb2); pack_p(P0, P1, pa0, pa1, pa2, pa3); } } while (0)
    f32x16 pA0, pA1, pB0, pB1; float alA = 1.f, alB = 1.f; bf16x8 pa0, pa1, pa2, pa3; constexpr int NT = SEQ / 64;
    constexpr int SE = 0, SO = SDEPTH - 1;
    SLOAD(SE, 0); asm volatile("s_waitcnt vmcnt(0)" ::: "memory"); SWRITE(0, SE); __syncthreads();
    QKT(pA0, pA1, K_lds); PARTIAL(pA0, pA1, alA, 0);
    SLOAD(SO, 64); if constexpr (SDEPTH == 2) { SLOAD(SE, 128); }
    SWAIT(); SWRITE(1, SO); __syncthreads();
    for (int j = 1; j + 1 < NT; j += 2) {
        SBAR(); QKT(pB0, pB1, K_lds + SHM_K);
        FINISH(pA0, pA1, alA, j - 1); SBAR();
        SLOAD(SO, (j + SDEPTH) * 64); SBAR();
        pv_d0(o, vb0, pa0, pa1, pa2, pa3); PARTIAL(pB0, pB1, alB, j);
        __syncthreads(); SWAIT(); SWRITE(0, SE);
        RESC(alB); __syncthreads();
        SBAR(); QKT(pA0, pA1, K_lds);
        FINISH(pB0, pB1, alB, j); SBAR();
        if (SDEPTH == 1 || j + 3 < NT) SLOAD(SE, (j + 1 + SDEPTH) * 64); SBAR();
        pv_d0(o, vb0 + SHM_V, pa0, pa1, pa2, pa3); PARTIAL(pA0, pA1, alA, j + 1);
        __syncthreads(); SWAIT(); SWRITE(1, SO);
        RESC(alA); __syncthreads();
    }
    SBAR(); QKT(pB0, pB1, K_lds + SHM_K);
    FINISH(pA0, pA1, alA, NT - 2); SBAR();
    pv_d0(o, vb0, pa0, pa1, pa2, pa3); PARTIAL(pB0, pB1, alB, NT - 1);
    __syncthreads(); RESC(alB);
    FINISH(pB0, pB1, alB, NT - 1); SBAR();
    pv_d0(o, vb0 + SHM_V, pa0, pa1, pa2, pa3);
    float rli[16];
    if constexpr (MODE == 0) {
        if (hi == 0) li_l[r32] = l_reg; asm volatile("s_waitcnt lgkmcnt(0)" ::: "memory");
#pragma unroll
        for (int r = 0; r < 16; ++r) rli[r] = __builtin_amdgcn_rcpf(li_l[crow(r, hi)]);
    } else {
#pragma unroll
        for (int r = 0; r < 16; ++r) rli[r] = 1.f;
    }
    bf16_t* Ow = A.O + (long)(A.q0 + wid * 32) * LDO;
#pragma unroll
    for (int r = 0; r < 16; ++r) { const int orow = crow(r, hi);
#pragma unroll
        for (int d0 = 0; d0 < 4; ++d0) { const float v = o[d0][r] * rli[r]; Ow[(long)orow * LDO + d0 * 32 + r32] = (bf16_t)(cvtpk(v, v) & 0xffffu); } }
    __syncthreads();
#undef KSWZ
#undef SLOAD
#undef SWRITE
#undef SWAIT
#undef RESC
#undef QKT
#undef PARTIAL
#undef FINISH
}
__device__ __forceinline__ int map_col(int id, int n) {
    if (id == 0) {
        if (n < 1024) { const int j = n & 127; return (n & ~127) + (j & 1) * 64 + (j >> 1); }
        if (n < 3456) return n;
        if (n < 3520) { const int j = n - 3456; return 3456 + (j & 1) * 32 + (j >> 1); }
        if (n < 3584) return -1;
        return n - 64;
    }
    if (id == 2) {
        if (n < 1024) return (n >> 7) * 192 + (n & 127);
        const int j = n - 1024, h = j >> 6, jj = j & 63; return h * 192 + 128 + (jj & 1) * 32 + (jj >> 1);
    }
    return n;
}
__device__ __forceinline__ void transpose_item(const float* W, int K, int Nsrc, bf16_t* WT, int row_off, int nblk, int mapid, const float* rowscale, LAS float* scr, int item, int lane) {
    const int kb = item / nblk, nb = item % nblk, k0 = 64 * kb, n0 = 32 * nb;
    const int sc = map_col(mapid, n0 + (lane & 31));
#pragma unroll 8
    for (int i = 0; i < 32; ++i) { const int kk = 2 * i + (lane >> 5); float v = sc >= 0 ? W[(size_t)(k0 + kk) * Nsrc + sc] : 0.f; if (rowscale) v *= rowscale[k0 + kk]; scr[kk * 33 + (lane & 31)] = v; }
    asm volatile("s_waitcnt lgkmcnt(0)" ::: "memory");
    const int c = lane & 7;
#pragma unroll
    for (int j = 0; j < 4; ++j) { const int n = (lane >> 3) + 8 * j; const LAS float* s = scr + (8 * c) * 33 + n;
        u32x4 o; o.x = cvtpk(s[0 * 33], s[1 * 33]); o.y = cvtpk(s[2 * 33], s[3 * 33]); o.z = cvtpk(s[4 * 33], s[5 * 33]); o.w = cvtpk(s[6 * 33], s[7 * 33]);
        *(u32x4*)(WT + (size_t)(row_off + n0 + n) * K + k0 + 8 * c) = o; }
    asm volatile("s_waitcnt lgkmcnt(0)" ::: "memory");
}
struct KP { const float* in[N_INPUTS]; float* out; unsigned char* ws; int lo, hi; };

__device__ __forceinline__ void prologue(const KP& p, unsigned char* lds) {
    int tid = threadIdx.x; asm volatile("" : "+v"(tid)); int Gd = gridDim.x, cb_ = blockIdx.x; asm volatile("" : "+s"(Gd), "+s"(cb_)); const int lane = tid & 63, wave = tid >> 6, G = Gd;
    float* sl = (float*)lds;
    float* red = (float*)(lds + 98304);
    for (int u = cb_; u < DEPTH * 48; u += G) {
        const int l = u / 48, cb = u % 48;
        for (int i = tid; i < NBATCH * DM; i += 512) { const int b = i >> 10, k = i & 1023; const float c = b < 16 ? p.in[I_CP][b * DM + k] : p.in[I_CS][(b - 16) * DM + k]; sl[i] = c * sigmoidf_(c); }
        __syncthreads();
        const int col = cb * 128 + (tid & 127), kq = tid >> 7;
        const float* W = p.in[I_WADA] + (size_t)l * DM * 6144 + (size_t)(kq * 256) * 6144 + col;
        float acc[NBATCH];
#pragma unroll
        for (int b = 0; b < NBATCH; ++b) acc[b] = 0.f;
        for (int k = 0; k < 256; ++k) { const float w = W[(size_t)k * 6144];
#pragma unroll
            for (int b = 0; b < NBATCH; ++b) acc[b] = fmaf(sl[b * DM + kq * 256 + k], w, acc[b]); }
        if (kq > 0) {
#pragma unroll
            for (int b = 0; b < NBATCH; ++b) red[((kq - 1) * NBATCH + b) * 128 + (tid & 127)] = acc[b];
        }
        __syncthreads();
        if (kq == 0) { float* ada = (float*)(p.ws + WS_ADA) + (size_t)l * NBATCH * 6144; const float bias = p.in[I_BADA][l * 6144 + col];
#pragma unroll
            for (int b = 0; b < NBATCH; ++b) ada[(size_t)b * 6144 + col] = acc[b] + red[(0 * NBATCH + b) * 128 + tid] + red[(1 * NBATCH + b) * 128 + tid] + red[(2 * NBATCH + b) * 128 + tid] + bias; }
        __syncthreads();
    }
    { float* cosR = (float*)(p.ws + WS_COSR); float* sinR = (float*)(p.ws + WS_SINR); float* cosM = (float*)(p.ws + WS_COSM); float* sinM = (float*)(p.ws + WS_SINM);
      for (int i = cb_ * 512 + tid; i < SEQ * 96; i += G * 512) {
          const int pos = i / 96, j = i % 96; const bool isr = j < 64; const int idx = isr ? j : j - 64;
          const float inv = isr ? exp2f(-13.287712379549449f * (float)idx * (1.0f / 64.0f)) : exp2f(-13.287712379549449f * (float)idx * (1.0f / 32.0f));
          const float ang = (float)pos * inv;
          const double tr = (double)ang * 0.15915494309189535; const double fr = tr - floor(tr);
          const float a2 = (float)(fr * 6.283185307179586);
          const float cs = cosf(a2), sn = sinf(a2);
          if (isr) { cosR[pos * 64 + idx] = cs; sinR[pos * 64 + idx] = sn; } else { cosM[pos * 32 + idx] = cs; sinM[pos * 32 + idx] = sn; }
      } }
    LAS float* scr = (LAS float*)((LAS unsigned char*)lds + wave * 16384);
    constexpr int IT_IN = 16 * 176, IT_SQ = 16 * 32, IT_UQ = 4 * 48, IT_UK = 2 * 32, IT_UP = 16 * 176, IT_DN = 44 * 32;
    constexpr int IT_LAYER = IT_IN + 3 * IT_SQ + IT_UQ + 2 * IT_UK + IT_UP + IT_DN;
    const int gw = cb_ * 8 + wave, NGW = G * 8;
    for (int it = gw; it < DEPTH * IT_LAYER; it += NGW) {
        const int l = it / IT_LAYER; int r = it % IT_LAYER; unsigned char* wl = p.ws + WS_W + (size_t)l * W_LAYER;
        if (r < IT_IN) { transpose_item(p.in[I_WIN] + (size_t)l * 1024 * 5568, 1024, 5568, (bf16_t*)(wl + WO_IN), 0, 176, 0, nullptr, scr, r, lane); continue; } r -= IT_IN;
        if (r < IT_SQ) { transpose_item(p.in[I_WRETO] + (size_t)l * 1024 * 1024, 1024, 1024, (bf16_t*)(wl + WO_RETO), 0, 32, 1, nullptr, scr, r, lane); continue; } r -= IT_SQ;
        if (r < IT_UQ) { transpose_item(p.in[I_WUQ] + (size_t)l * 256 * 1536, 256, 1536, (bf16_t*)(wl + WO_UQ), 0, 48, 2, p.in[I_QNG] + l * 256, scr, r, lane); continue; } r -= IT_UQ;
        if (r < IT_UK) { transpose_item(p.in[I_WUK] + (size_t)l * 128 * 1024, 128, 1024, (bf16_t*)(wl + WO_UKV), 0, 32, 1, p.in[I_KVNG] + l * 128, scr, r, lane); continue; } r -= IT_UK;
        if (r < IT_UK) { transpose_item(p.in[I_WUV] + (size_t)l * 128 * 1024, 128, 1024, (bf16_t*)(wl + WO_UKV), 1024, 32, 1, p.in[I_KVNG] + l * 128, scr, r, lane); continue; } r -= IT_UK;
        if (r < IT_SQ) { transpose_item(p.in[I_WMLAO] + (size_t)l * 1024 * 1024, 1024, 1024, (bf16_t*)(wl + WO_MLAO), 0, 32, 1, nullptr, scr, r, lane); continue; } r -= IT_SQ;
        if (r < IT_SQ) { transpose_item(p.in[I_WOUT] + (size_t)l * 1024 * 1024, 1024, 1024, (bf16_t*)(wl + WO_OUT), 0, 32, 1, nullptr, scr, r, lane); continue; } r -= IT_SQ;
        if (r < IT_UP) { transpose_item(p.in[I_WUP] + (size_t)l * 1024 * 5632, 1024, 5632, (bf16_t*)(wl + WO_UP), 0, 176, 1, nullptr, scr, r, lane); continue; } r -= IT_UP;
        transpose_item(p.in[I_WDOWN] + (size_t)l * 2816 * 1024, 2816, 1024, (bf16_t*)(wl + WO_DOWN), 0, 32, 1, nullptr, scr, r, lane);
    }
}

template <int MODE> __device__ __forceinline__ void row_phase(const KP& p, int g, const float* lng, const float* lnb, const float* mod  ) {
    int tid = threadIdx.x; asm volatile("" : "+v"(tid)); int Gd = gridDim.x, cb_ = blockIdx.x; asm volatile("" : "+s"(Gd), "+s"(cb_)); const int lane = tid & 63, gw = cb_ * 8 + (tid >> 6), NGW = Gd * 8;
    bf16_t* H = (bf16_t*)(p.ws + WS_H);
    for (int r = gw; r < T; r += NGW) {
        const int gr = g * T + r, b = gr >> 11;
        float* xrow = p.out + (size_t)gr * DM;
        const float* src = MODE == 0 ? (gr < 16 * SEQ ? p.in[I_XP] + (size_t)gr * DM : p.in[I_XS] + (size_t)(gr - 16 * SEQ) * DM) : xrow;
        f32x4 v[4];
#pragma unroll
        for (int j = 0; j < 4; ++j) v[j] = *((const f32x4*)src + lane + 64 * j);
        if (MODE != 0) {
            float s = 0.f;
#pragma unroll
            for (int j = 0; j < 4; ++j) s += (v[j][0] + v[j][1]) + (v[j][2] + v[j][3]);
            const float mean = wave_sum(s) * (1.f / DM); float s2 = 0.f;
#pragma unroll
            for (int j = 0; j < 4; ++j) { v[j] = v[j] - mean; s2 += (v[j][0] * v[j][0] + v[j][1] * v[j][1]) + (v[j][2] * v[j][2] + v[j][3] * v[j][3]); }
            const float rstd = rsqrtf(wave_sum(s2) * (1.f / DM) + LN_EPS);
#pragma unroll
            for (int j = 0; j < 4; ++j) { const f32x4 gg = *((const f32x4*)lng + lane + 64 * j), bb = *((const f32x4*)lnb + lane + 64 * j); v[j] = v[j] * rstd * gg + bb; }
        }
#pragma unroll
        for (int j = 0; j < 4; ++j) *((f32x4*)xrow + lane + 64 * j) = v[j];
        if (mod) {
            float s = 0.f;
#pragma unroll
            for (int j = 0; j < 4; ++j) s += (v[j][0] + v[j][1]) + (v[j][2] + v[j][3]);
            const float mean = wave_sum(s) * (1.f / DM); float s2 = 0.f;
#pragma unroll
            for (int j = 0; j < 4; ++j) { v[j] = v[j] - mean; s2 += (v[j][0] * v[j][0] + v[j][1] * v[j][1]) + (v[j][2] * v[j][2] + v[j][3] * v[j][3]); }
            const float rstd = rsqrtf(wave_sum(s2) * (1.f / DM) + LN_EPS);
            const float* mb = mod + (size_t)b * 6144;
#pragma unroll
            for (int j = 0; j < 4; ++j) { const f32x4 sh = *((const f32x4*)mb + lane + 64 * j), sc = *((const f32x4*)(mb + 1024) + lane + 64 * j);
                const f32x4 h = v[j] * rstd * (sc + 1.0f) + sh;
                unsigned long long w = (unsigned long long)cvtpk(h[0], h[1]) | ((unsigned long long)cvtpk(h[2], h[3]) << 32);
                *((unsigned long long*)(H + (size_t)r * DM) + lane + 64 * j) = w; }
        }
    }
}
__device__ __forceinline__ void rogate_phase(const KP& p, const float* gn) {
    int tid = threadIdx.x; asm volatile("" : "+v"(tid)); int Gd = gridDim.x, cb_ = blockIdx.x; asm volatile("" : "+s"(Gd), "+s"(cb_)); const int lane = tid & 63, gw = cb_ * 8 + (tid >> 6), NGW = Gd * 8;
    bf16_t* RO = (bf16_t*)(p.ws + WS_RO); const bf16_t* GR = (const bf16_t*)(p.ws + WS_GR);
    const int c0 = (lane >> 4) * 256 + (lane & 15) * 8;
    for (int r = gw; r < T; r += NGW) {
        f32x4 a[4];
        unpack8(*(const u32x4*)(RO + (size_t)r * 1024 + c0), a[0], a[1]); unpack8(*(const u32x4*)(RO + (size_t)r * 1024 + c0 + 128), a[2], a[3]);
        float s = 0.f;
#pragma unroll
        for (int j = 0; j < 4; ++j) s += (a[j][0] + a[j][1]) + (a[j][2] + a[j][3]);
        s += __shfl_xor(s, 1); s += __shfl_xor(s, 2); s += __shfl_xor(s, 4); s += __shfl_xor(s, 8);
        const float mean = s * (1.f / 256.f); float s2 = 0.f;
#pragma unroll
        for (int j = 0; j < 4; ++j) { a[j] = a[j] - mean; s2 += (a[j][0] * a[j][0] + a[j][1] * a[j][1]) + (a[j][2] * a[j][2] + a[j][3] * a[j][3]); }
        s2 += __shfl_xor(s2, 1); s2 += __shfl_xor(s2, 2); s2 += __shfl_xor(s2, 4); s2 += __shfl_xor(s2, 8);
        const float rstd = rsqrtf(s2 * (1.f / 256.f) + LN_EPS);
#pragma unroll
        for (int hh = 0; hh < 2; ++hh) {
            f32x4 g0, g1; unpack8(*(const u32x4*)(GR + (size_t)r * 1024 + c0 + hh * 128), g0, g1);
            const f32x4 w0 = *(const f32x4*)(gn + c0 + hh * 128), w1 = *(const f32x4*)(gn + c0 + hh * 128 + 4);
            *(u32x4*)(RO + (size_t)r * 1024 + c0 + hh * 128) = pack8(a[2 * hh] * rstd * w0 * g0, a[2 * hh + 1] * rstd * w1 * g1);
        }
    }
}
__device__ __forceinline__ void conv_phase(const KP& p, const float* cw, const float* cb) {
    const bf16_t* AB = (const bf16_t*)(p.ws + WS_AB); bf16_t* U = (bf16_t*)(p.ws + WS_U);
    constexpr int CH = DFF / 8;
    int tid = threadIdx.x; asm volatile("" : "+v"(tid)); int Gd = gridDim.x, cb_ = blockIdx.x; asm volatile("" : "+s"(Gd), "+s"(cb_));
    for (int it = cb_ * 512 + tid; it < T * CH; it += Gd * 512) {
        const int r = it / CH, c = (it % CH) * 8, pos = r & (SEQ - 1);
        f32x4 a0, a1, t0, t1, acc0, acc1;
        { const f32x4 w0 = *(const f32x4*)(cw + DFF + c), w1 = *(const f32x4*)(cw + DFF + c + 4); unpack8(*(const u32x4*)(AB + (size_t)r * NUP + c), a0, a1);
          acc0 = a0 * w0 + *(const f32x4*)(cb + c); acc1 = a1 * w1 + *(const f32x4*)(cb + c + 4); }
        if (pos > 0) { const f32x4 w0 = *(const f32x4*)(cw + c), w1 = *(const f32x4*)(cw + c + 4); unpack8(*(const u32x4*)(AB + (size_t)(r - 1) * NUP + c), t0, t1); acc0 += t0 * w0; acc1 += t1 * w1; }
        if (pos < SEQ - 1) { const f32x4 w0 = *(const f32x4*)(cw + 2 * DFF + c), w1 = *(const f32x4*)(cw + 2 * DFF + c + 4); unpack8(*(const u32x4*)(AB + (size_t)(r + 1) * NUP + c), t0, t1); acc0 += t0 * w0; acc1 += t1 * w1; }
        unpack8(*(const u32x4*)(AB + (size_t)r * NUP + DFF + c), t0, t1);
        const f32x2 g0 = pg8::gelu_pk((f32x2){acc0[0], acc0[1]}), g1 = pg8::gelu_pk((f32x2){acc0[2], acc0[3]}), g2 = pg8::gelu_pk((f32x2){acc1[0], acc1[1]}), g3 = pg8::gelu_pk((f32x2){acc1[2], acc1[3]});
        const f32x4 o0 = (f32x4){g0.x, g0.y, g1.x, g1.y} * t0, o1 = (f32x4){g2.x, g2.y, g3.x, g3.y} * t1;
        *(u32x4*)(U + (size_t)r * DFF + c) = pack8(o0, o1);
    }
}
#ifndef MK_PHASES
#define MK_PHASES 0xFFFF
#endif
#define PH(k) if constexpr ((MK_PHASES >> (k)) & 1)
template <class Epi> __device__ __forceinline__ void run_gemm(unsigned char* lds, const bf16_t* A, const bf16_t* Bt, int N, int K, const Epi& E) {
    asm volatile("" : "+s"(K));
    pg8::Gemm g{A, Bt, T, N, K}; pg8::StaticOrder S; int Gd = gridDim.x, cb_ = blockIdx.x; asm volatile("" : "+s"(Gd), "+s"(cb_)); S.init(T, N, Gd, cb_);
    pg8::gemm_phase<Epi, pg8::StaticOrder, true, true>((PG8_LAS unsigned char*)lds, g, S, E);
}
typedef const __attribute__((address_space(4))) KP* KPC;
__global__ void __launch_bounds__(512) mega(KP p_arg) {
    extern __shared__ __attribute__((aligned(16))) unsigned char lds[];
    cg::grid_group grid = cg::this_grid();
    int s = 0; const int s_lo = p_arg.lo, s_hi = p_arg.hi;
#define STEP_BEGIN if (s >= s_lo && s < s_hi) { if (s > s_lo) grid.sync(); \
        KPC kp = (KPC)__builtin_amdgcn_kernarg_segment_ptr(); int l = l_, g = g_; asm volatile("" : "+s"(kp), "+s"(l), "+s"(g)); \
        int G = gridDim.x, cblk = blockIdx.x; asm volatile("" : "+s"(G), "+s"(cblk)); (void)G; (void)cblk; \
        KP p; _Pragma("unroll") for (int i_ = 0; i_ < N_INPUTS; ++i_) p.in[i_] = kp->in[i_]; p.out = kp->out; p.ws = kp->ws; p.lo = 0; p.hi = 0; unsigned char* ws = p.ws; \
        const unsigned char* wl = ws + WS_W + (size_t)l * W_LAYER; (void)wl; \
        const float* ada_l = (const float*)(ws + WS_ADA) + (size_t)l * NBATCH * 6144; (void)ada_l;     \
        const float* ada_g = ada_l + (size_t)(g * GSEQ) * 6144; (void)ada_g;                           \
        float* xg = p.out + (size_t)g * T * DM; (void)xg;
#define STEP_END } ++s;
    { const int l_ = 0, g_ = 0; STEP_BEGIN PH(0) prologue(p, (unsigned char*)lds); STEP_END }
    for (int g_ = 0; g_ < NG; ++g_) {
        for (int l_ = 0; l_ < DEPTH; ++l_) {
            if (l_ == 0) { STEP_BEGIN PH(11) row_phase<0>(p, g, nullptr, nullptr, ada_l); STEP_END }
            STEP_BEGIN PH(1) { EpiIn E; E.ws = ws; run_gemm(lds, (const bf16_t*)(ws + WS_H), (const bf16_t*)(wl + WO_IN), NIN, 1024, E); } STEP_END
            STEP_BEGIN {
                PH(2) for (int L = cblk; L < 512; L += G) {
                    const int x = L & 7, j = L >> 3, qb = j & 7, bh = (j >> 3) * 8 + x, b = bh >> 3, h = (bh & 7) >> 1, dvh = bh & 1;
                    const float df = p.in[I_RDF][l * 4 + h], db = p.in[I_RDB][l * 4 + h];
                    FaArgs A; const size_t rb = (size_t)b * SEQ;
                    A.Q1 = (const bf16_t*)(ws + WS_QR) + rb * 512 + h * 128; A.Q2 = nullptr;
                    A.K1 = (const bf16_t*)(ws + WS_KR) + rb * 512 + h * 128; A.K2 = nullptr;
                    A.V = (const bf16_t*)(ws + WS_VR) + rb * 1024 + h * 256 + dvh * 128;
                    A.O = (bf16_t*)(ws + WS_RO) + rb * 1024 + h * 256 + dvh * 128; A.q0 = qb * 256;
                    A.lf2 = -log1pf(expf(-df)) * 1.4426950408889634f; A.nlb2 = log1pf(expf(-db)) * 1.4426950408889634f;
                    flash_unit<1>(A, (char*)lds);
                }
                PH(12) { EpiUQ E; E.ws = ws; run_gemm(lds, (const bf16_t*)(ws + WS_DQ), (const bf16_t*)(wl + WO_UQ), 1536, 256, E); }
                PH(14) { EpiUKV E; E.ws = ws; run_gemm(lds, (const bf16_t*)(ws + WS_DKV), (const bf16_t*)(wl + WO_UKV), 2048, 128, E); }
            } STEP_END
            STEP_BEGIN {
                PH(3) for (int L = cblk; L < 512; L += G) {
                    const int x = L & 7, j = L >> 3, qb = j & 7, bh = (j >> 3) * 8 + x, b = bh >> 3, h = bh & 7;
                    FaArgs A; const size_t rb = (size_t)b * SEQ;
                    A.Q1 = (const bf16_t*)(ws + WS_QN) + rb * 1024 + h * 128; A.Q2 = (const bf16_t*)(ws + WS_QRP) + rb * 512 + h * 64;
                    A.K1 = (const bf16_t*)(ws + WS_KN) + rb * 1024 + h * 128; A.K2 = (const bf16_t*)(ws + WS_KROPE) + rb * 64;
                    A.V = (const bf16_t*)(ws + WS_VM) + rb * 1024 + h * 128;
                    A.O = (bf16_t*)(ws + WS_AO) + rb * 1024 + h * 128; A.q0 = qb * 256; A.lf2 = 0.f; A.nlb2 = 0.f;
                    flash_unit<0>(A, (char*)lds);
                }
                PH(13) rogate_phase(p, p.in[I_GN] + l * 1024);
            } STEP_END
            STEP_BEGIN {
                PH(4) { EpiMerge<true> E; E.ws = ws; run_gemm(lds, (const bf16_t*)(ws + WS_RO), (const bf16_t*)(wl + WO_RETO), 1024, 1024, E); }
                PH(4) { EpiMerge<false> E; E.ws = ws; run_gemm(lds, (const bf16_t*)(ws + WS_AO), (const bf16_t*)(wl + WO_MLAO), 1024, 1024, E); }
            } STEP_END
            STEP_BEGIN PH(5) { EpiRes E; E.x = xg; E.gate = ada_g + 2048; run_gemm(lds, (const bf16_t*)(ws + WS_MG), (const bf16_t*)(wl + WO_OUT), 1024, 1024, E); } STEP_END
            STEP_BEGIN PH(6) row_phase<1>(p, g, p.in[I_LN1G] + l * DM, p.in[I_LN1B] + l * DM, ada_l + 3072); STEP_END
            STEP_BEGIN PH(7) { EpiUp E; E.ws = ws; run_gemm(lds, (const bf16_t*)(ws + WS_H), (const bf16_t*)(wl + WO_UP), NUP, 1024, E); } STEP_END
            STEP_BEGIN PH(8) conv_phase(p, p.in[I_CONVW] + (size_t)l * 3 * DFF, p.in[I_CONVB] + (size_t)l * DFF); STEP_END
            STEP_BEGIN PH(9) { EpiRes E; E.x = xg; E.gate = ada_g + 5120; run_gemm(lds, (const bf16_t*)(ws + WS_U), (const bf16_t*)(wl + WO_DOWN), 1024, DFF, E); } STEP_END
            STEP_BEGIN PH(10) row_phase<2>(p, g, p.in[I_LN2G] + l * DM, p.in[I_LN2B] + l * DM, l + 1 < DEPTH ? ada_l + (size_t)NBATCH * 6144 : nullptr); STEP_END
        }
    }
#undef STEP_BEGIN
#undef STEP_END
}
}

extern "C" void kernel_launch(void* const* d_in, const int* in_sizes, int n_in, void* d_out, int out_size, void* d_ws, size_t ws_size, hipStream_t stream) {
    static int grid = 0;
    if (grid == 0) {
        if (n_in != mk::N_INPUTS || ws_size < mk::WS_END) { fprintf(stderr, "kernel_launch: unexpected n_in %d / ws %zu\n", n_in, ws_size); grid = -1; return; }
        int dev = 0, cus = 0, per_cu = 0;
        hipGetDevice(&dev); hipDeviceGetAttribute(&cus, hipDeviceAttributeMultiprocessorCount, dev);
        if (hipFuncSetAttribute((const void*)mk::mega, hipFuncAttributeMaxDynamicSharedMemorySize, mk::LDS_BYTES) != hipSuccess) { fprintf(stderr, "kernel_launch: hipFuncSetAttribute failed\n"); grid = -1; return; }
        if (hipOccupancyMaxActiveBlocksPerMultiprocessor(&per_cu, (const void*)mk::mega, 512, mk::LDS_BYTES) != hipSuccess || per_cu < 1) { fprintf(stderr, "kernel_launch: occupancy query says %d\n", per_cu); per_cu = 1; }
        (void)hipGetLastError();
        grid = cus * per_cu;
        fprintf(stderr, "kernel_launch: grid %d (cus %d x %d)\n", grid, cus, per_cu);
    }
    if (grid < 0) return;
    mk::KP p{};
    for (int i = 0; i < mk::N_INPUTS; ++i) p.in[i] = (const float*)d_in[i];
    p.out = (float*)d_out; p.ws = (unsigned char*)d_ws; p.lo = 0; p.hi = 1 << 30;
    void* args[] = {&p};
    hipError_t e = hipLaunchCooperativeKernel((const void*)mk::mega, dim3(grid), dim3(512), args, mk::LDS_BYTES, stream);
    if (e != hipSuccess) fprintf(stderr, "kernel_launch: cooperative launch failed: %s (grid %d)\n", hipGetErrorString(e), grid);
}
```

```cpp
#include <hip/hip_runtime.h>
#include <hip/hip_cooperative_groups.h>
#include <cstdio>
#include <cstdint>
namespace cg = cooperative_groups;
namespace pg8 {
#define PG8_LAS __attribute__((address_space(3)))
typedef unsigned short bf16_t;
typedef short bf16x8 __attribute__((ext_vector_type(8)));
typedef float f32x4 __attribute__((ext_vector_type(4)));
typedef unsigned u32x4 __attribute__((ext_vector_type(4)));
constexpr int BM = 256, BK = 64, HALF = 128, HTB = HALF * BK * 2  , STAGE_BYTES = 8 * HTB, NXCD = 8, WGM = 8;

__host__ __device__ __forceinline__ int lds_byte(int r, int c) { const int st = (r >> 4) * 2 + (c >> 5), rr = r & 15, cc = c & 31, ob = rr * 64 + cc * 2; return st * 1024 + (ob ^ (((ob >> 9) & 1) << 5)); }
__host__ __device__ __forceinline__ void stage_rc(int b, int& R, int& C) { const int st = b / 1024, sb = b % 1024, swz = sb ^ (((sb >> 9) & 1) << 5); R = (st >> 1) * 16 + swz / 64; C = (st & 1) * 32 + (swz % 64) / 2; }
__host__ __device__ __forceinline__ int perm32(int rho) { const int n = rho >> 4, i = rho & 15; return 8 * (i >> 2) + 4 * n + (i & 3); }

struct Unit { int pm, pn; };
struct Gemm { const bf16_t* A; const bf16_t* Bt; int M, N, K; };

struct StaticOrder {
    int nM, nN, nwg, G, c;
    __host__ __device__ void init(int M, int N, int G_, int c_) { nM = M / BM; nN = N / BM; nwg = nM * nN; G = G_; c = c_; }
    __host__ __device__ bool next(int i, Unit& u) const {
        const long L = (long)i * G + c; if (L >= nwg) return false;
        int wgid = (int)L; { const int q = nwg / NXCD, r = nwg % NXCD, xcd = wgid % NXCD, off = wgid / NXCD; wgid = (xcd < r ? xcd * (q + 1) : r * (q + 1) + (xcd - r) * q) + off; }
        const int nig = WGM * nN, gid = wgid / nig, fm = gid * WGM, gsz = (nM - fm) < WGM ? (nM - fm) : WGM;
        u.pm = fm + ((wgid % nig) % gsz); u.pn = (wgid % nig) / gsz; return true;
    }
    __device__ __forceinline__ void a_ready(const Unit&) const {}
    __device__ __forceinline__ void done(const Unit&) const {}
};

__device__ __forceinline__ unsigned cvt_pk_bf16(float lo, float hi) { unsigned r; asm volatile("v_cvt_pk_bf16_f32 %0, %1, %2" : "=v"(r) : "v"(lo), "v"(hi)); return r; }
typedef float f32x2 __attribute__((ext_vector_type(2)));
__device__ __forceinline__ f32x2 gelu_pk(f32x2 v) {
    const f32x2 av = __builtin_elementwise_abs(v), d = av * 0.2316418882f + 1.0f;
    f32x2 t; t.x = __builtin_amdgcn_rcpf(d.x); t.y = __builtin_amdgcn_rcpf(d.y);
    f32x2 q = t * 0.5307027145f + (-0.7265760135f); q = q * t + 0.7107068705f; q = q * t + (-0.142248368f); q = q * t + 0.127414796f; q = q * t;
    const f32x2 s = (v * v) * (-0.72134752044f);
    f32x2 e; e.x = __builtin_amdgcn_exp2f(s.x); e.y = __builtin_amdgcn_exp2f(s.y);
    const f32x2 m = v * (q * e), r = v - m;
    f32x2 o; o.x = v.x < 0.f ? m.x : r.x; o.y = v.y < 0.f ? m.y : r.y; return o;
}

template <class Epi, class Sched, bool ALIGN_EPI = false, bool SP2 = false>
__device__ __forceinline__ void gemm_phase(PG8_LAS unsigned char* lds, const Gemm g, const Sched& S, const Epi& E, const int wv_) {
    int tid; asm volatile("v_mbcnt_lo_u32_b32 %0, -1, 0\n\tv_mbcnt_hi_u32_b32 %0, -1, %0" : "=v"(tid)); tid += wv_ * 64; const int wid = __builtin_amdgcn_readfirstlane(tid >> 6), lane = tid & 63, wr = wid >> 2, wc = wid & 3, fr = lane & 15, fq = lane >> 4;
    const int K = g.K, nt = K / BK;
    unsigned voffA[2], voffB[2];
#pragma unroll
    for (int i = 0; i < 2; ++i) { int R, C; stage_rc(tid * 16 + i * 8192, R, C); const int Rb = Epi::PERM ? ((R & ~31) + perm32(R & 31)) : R;
        voffA[i] = (unsigned)(R * K + C) * 2u; voffB[i] = (unsigned)(Rb * K + C) * 2u; }
    const size_t kstep = (size_t)(BK * 2);
    const size_t hstep = (size_t)HALF * K * 2;
    const size_t tstep = 2 * hstep;
    const unsigned ldsw = (unsigned)wid * 1024u;
    const int aoff = lds_byte(wr * 64 + fr, fq * 8), boff = lds_byte(wc * 32 + fr, fq * 8);
#define PG8_SA(b, h) (((b) * 2 + (h)) * HTB)
#define PG8_SB(b, h) ((4 + (b) * 2 + (h)) * HTB)
#define PG8_STAGE(bufoff, gbase, voff) do { _Pragma("unroll") for (int _i = 0; _i < 2; ++_i) \
        __builtin_amdgcn_global_load_lds((const unsigned*)((const char*)(gbase) + (voff)[_i]), (PG8_LAS unsigned*)(lds + (bufoff) + ldsw + _i * 8192), 16, 0, 0); } while (0)
#define PG8_LDA(dst, b, h) do { _Pragma("unroll") for (int m = 0; m < 4; ++m) _Pragma("unroll") for (int k = 0; k < 2; ++k) dst[m][k] = *(const PG8_LAS bf16x8*)(lds + PG8_SA(b, h) + aoff + m * 2048 + k * 1024); } while (0)
#define PG8_LDB(dst, b, h) do { _Pragma("unroll") for (int n = 0; n < 2; ++n) _Pragma("unroll") for (int k = 0; k < 2; ++k) dst[n][k] = *(const PG8_LAS bf16x8*)(lds + PG8_SB(b, h) + boff + n * 2048 + k * 1024); } while (0)
#define PG8_MMA(ai, bj, At, Bt) do { __builtin_amdgcn_s_setprio(1); _Pragma("unroll") for (int m = 0; m < 4; ++m) _Pragma("unroll") for (int n = 0; n < 2; ++n) _Pragma("unroll") for (int k = 0; k < 2; ++k) \
        acc[ai][bj][m][n] = __builtin_amdgcn_mfma_f32_16x16x32_bf16(Bt[n][k], At[m][k], acc[ai][bj][m][n], 0, 0, 0); __builtin_amdgcn_s_setprio(0); } while (0)
#define PG8_WAIT_V(n) asm volatile("s_waitcnt vmcnt(" #n ")" ::: "memory")
#define PG8_WAIT_L(n) asm volatile("s_waitcnt lgkmcnt(" #n ")" ::: "memory")
#define PG8_BAR __builtin_amdgcn_s_barrier()
#define PG8_SCHED __builtin_amdgcn_sched_barrier(0)
    Unit cur, nxt; int ui = 0;
    if (!S.next(0, cur)) return;
    f32x4 acc[2][2][4][2];
#pragma unroll
    for (int a = 0; a < 2; ++a)
#pragma unroll
        for (int b = 0; b < 2; ++b)
#pragma unroll
            for (int m = 0; m < 4; ++m)
#pragma unroll
                for (int n = 0; n < 2; ++n) acc[a][b][m][n] = (f32x4){0.f, 0.f, 0.f, 0.f};
    bf16x8 At[4][2], B0[2][2], B1[2][2];
    const char* cA = (const char*)g.A + (size_t)cur.pm * tstep; const char* cB = (const char*)g.Bt + (size_t)cur.pn * tstep;
    S.a_ready(cur);
    if constexpr (SP2) {
        PG8_STAGE(PG8_SB(0, 0), cB, voffB); PG8_STAGE(PG8_SB(0, 1), cB + hstep, voffB); PG8_STAGE(PG8_SA(0, 0), cA, voffA); PG8_STAGE(PG8_SA(0, 1), cA + hstep, voffA);
        if (wr == 1) PG8_BAR;
        PG8_WAIT_V(2); PG8_BAR;
        PG8_STAGE(PG8_SB(1, 0), cB + kstep, voffB); PG8_STAGE(PG8_SA(1, 0), cA + kstep, voffA); PG8_STAGE(PG8_SB(1, 1), cB + hstep + kstep, voffB);
        PG8_WAIT_V(6); PG8_BAR;
    } else {
        PG8_STAGE(PG8_SB(0, 0), cB, voffB); PG8_STAGE(PG8_SA(0, 0), cA, voffA); PG8_STAGE(PG8_SB(0, 1), cB + hstep, voffB); PG8_STAGE(PG8_SA(0, 1), cA + hstep, voffA);
        if (wr == 1) PG8_BAR;
        PG8_WAIT_V(4); PG8_BAR;
        PG8_STAGE(PG8_SB(1, 0), cB + kstep, voffB); PG8_STAGE(PG8_SA(1, 0), cA + kstep, voffA); PG8_STAGE(PG8_SB(1, 1), cB + hstep + kstep, voffB);
        PG8_WAIT_V(6); PG8_BAR;
    }
    for (;;) {
        const bool has_next = S.next(ui + 1, nxt);
        const char* nA = has_next ? (const char*)g.A + (size_t)nxt.pm * tstep : cA; const char* nB = has_next ? (const char*)g.Bt + (size_t)nxt.pn * tstep : cB;
        for (int t = 0; t < nt; t += 2) {
            const bool last = (t == nt - 2);
            const char* a1 = cA + (size_t)(t + 1) * kstep;
            const char* a2 = last ? nA : cA + (size_t)(t + 2) * kstep; const char* b2 = last ? nB : cB + (size_t)(t + 2) * kstep;
            const char* a3 = a2 + kstep; const char* b3 = b2 + kstep;
            if (last && has_next) S.a_ready(nxt);
            if constexpr (SP2) {
            PG8_LDB(B0, 0, 0); PG8_LDB(B1, 0, 1); PG8_SCHED; PG8_LDA(At, 0, 0); PG8_STAGE(PG8_SA(1, 1), a1 + hstep, voffA);
            PG8_WAIT_V(8); PG8_WAIT_L(0); PG8_BAR; PG8_MMA(0, 0, At, B0); PG8_MMA(0, 1, At, B1); PG8_BAR; PG8_SCHED;
            PG8_LDA(At, 0, 1); PG8_STAGE(PG8_SB(0, 0), b2, voffB); PG8_STAGE(PG8_SB(0, 1), b2 + hstep, voffB); PG8_STAGE(PG8_SA(0, 0), a2, voffA);
            PG8_WAIT_V(8); PG8_WAIT_L(0); PG8_BAR; PG8_MMA(1, 0, At, B0); PG8_MMA(1, 1, At, B1); PG8_BAR; PG8_SCHED;
            PG8_LDB(B0, 1, 0); PG8_LDB(B1, 1, 1); PG8_SCHED; PG8_LDA(At, 1, 0); PG8_STAGE(PG8_SA(0, 1), a2 + hstep, voffA);
            PG8_WAIT_V(8); PG8_WAIT_L(0); PG8_BAR; PG8_MMA(0, 0, At, B0); PG8_MMA(0, 1, At, B1); PG8_BAR; PG8_SCHED;
            PG8_LDA(At, 1, 1); PG8_STAGE(PG8_SB(1, 0), b3, voffB); PG8_STAGE(PG8_SB(1, 1), b3 + hstep, voffB); PG8_STAGE(PG8_SA(1, 0), a3, voffA);
            PG8_WAIT_V(8); PG8_WAIT_L(0); PG8_BAR; PG8_MMA(1, 0, At, B0); PG8_MMA(1, 1, At, B1); PG8_BAR; PG8_SCHED;
            } else {
            PG8_LDB(B0, 0, 0); PG8_SCHED; PG8_LDA(At, 0, 0); PG8_STAGE(PG8_SA(1, 1), a1 + hstep, voffA);
            PG8_WAIT_L(8); PG8_BAR; PG8_WAIT_L(0); PG8_MMA(0, 0, At, B0); PG8_BAR; PG8_SCHED;
            PG8_LDB(B1, 0, 1); PG8_STAGE(PG8_SB(0, 0), b2, voffB);
            PG8_BAR; PG8_WAIT_L(0); PG8_MMA(0, 1, At, B1); PG8_BAR;
            PG8_LDA(At, 0, 1); PG8_STAGE(PG8_SA(0, 0), a2, voffA);
            PG8_BAR; PG8_WAIT_L(0); PG8_MMA(1, 0, At, B0); PG8_BAR; PG8_SCHED;
            PG8_STAGE(PG8_SB(0, 1), b2 + hstep, voffB);
            PG8_WAIT_V(6); PG8_BAR; PG8_MMA(1, 1, At, B1); PG8_BAR;
            PG8_LDB(B0, 1, 0); PG8_SCHED; PG8_LDA(At, 1, 0); PG8_STAGE(PG8_SA(0, 1), a2 + hstep, voffA);
            PG8_WAIT_L(8); PG8_BAR; PG8_WAIT_L(0); PG8_MMA(0, 0, At, B0); PG8_BAR; PG8_SCHED;
            PG8_LDB(B1, 1, 1); PG8_STAGE(PG8_SB(1, 0), b3, voffB);
            PG8_BAR; PG8_WAIT_L(0); PG8_MMA(0, 1, At, B1); PG8_BAR;
            PG8_LDA(At, 1, 1); PG8_STAGE(PG8_SA(1, 0), a3, voffA);
            PG8_BAR; PG8_WAIT_L(0); PG8_MMA(1, 0, At, B0); PG8_BAR; PG8_SCHED;
            PG8_STAGE(PG8_SB(1, 1), b3 + hstep, voffB);
            PG8_WAIT_V(6); PG8_BAR; PG8_MMA(1, 1, At, B1); PG8_BAR;
            }
        }
        if constexpr (ALIGN_EPI) { if (wr == 0) PG8_BAR; }
        if constexpr (!Epi::AFTER_DRAIN) { E(acc, cur, wr, wc, fr, fq); S.done(cur); }
        if (!has_next) break;
#pragma unroll
        for (int a = 0; a < 2; ++a)
#pragma unroll
            for (int b = 0; b < 2; ++b)
#pragma unroll
                for (int m = 0; m < 4; ++m)
#pragma unroll
                    for (int n = 0; n < 2; ++n) acc[a][b][m][n] = (f32x4){0.f, 0.f, 0.f, 0.f};
        cur = nxt; cA = nA; cB = nB; ++ui;
        if constexpr (ALIGN_EPI) { if (wr == 1) PG8_BAR; }
    }
    PG8_WAIT_V(0);
    if constexpr (!ALIGN_EPI) { if (wr == 0) PG8_BAR; }
    PG8_BAR;
    if constexpr (Epi::AFTER_DRAIN) { E.fused(acc, cur, wr, wc, fr, fq, lds, wid, lane); S.done(cur); }
#undef PG8_SA
#undef PG8_SB
#undef PG8_STAGE
#undef PG8_LDA
#undef PG8_LDB
#undef PG8_MMA
#undef PG8_WAIT_V
#undef PG8_WAIT_L
#undef PG8_BAR
#undef PG8_SCHED
}
}
namespace mk {
using pg8::bf16_t; using pg8::f32x4; using pg8::u32x4; using pg8::Unit; using pg8::f32x2;
typedef short bf16x8 __attribute__((ext_vector_type(8)));
typedef short s16x4 __attribute__((ext_vector_type(4)));
typedef float f32x16 __attribute__((ext_vector_type(16)));
#define LAS __attribute__((address_space(3)))

constexpr int DM = 1024, SEQ = 2048, NBATCH = 24, DEPTH = 4;
constexpr int GSEQ = 8, T = GSEQ * SEQ, NG = NBATCH / GSEQ;
constexpr int NIN = 5632, NUP = 5632, DFF = 2816;
constexpr float LN_EPS = 1e-5f, RMS_EPS = 1e-6f;
constexpr float ALPHA = 1.681792830507429f;
constexpr float QSCALE = 0.07216878364870322f * 1.4426950408889634f;
constexpr float RKSCALE = 0.08838834764831845f;
enum { I_XP = 0, I_XS, I_CP, I_CS, I_WADA, I_BADA, I_WIN, I_RDF, I_RDB, I_GN, I_WRETO, I_QNG, I_KVNG, I_WUQ, I_WUK, I_WUV, I_WMLAO, I_WOUT,
       I_LN1G, I_LN1B, I_WUP, I_CONVW, I_CONVB, I_WDOWN, I_LN2G, I_LN2B, N_INPUTS };
constexpr size_t MiB = 1u << 20;
constexpr size_t WS_ADA = 1 * MiB, WS_COSR = 4 * MiB, WS_SINR = 4 * MiB + 512 * 1024, WS_COSM = 5 * MiB, WS_SINM = 5 * MiB + 256 * 1024;
constexpr size_t WS_SSQQ = 5 * MiB + 512 * 1024, WS_SSQKV = 5 * MiB + 768 * 1024;
constexpr size_t WS_W = 6 * MiB;
constexpr size_t WO_IN = 0, WO_RETO = WO_IN + (size_t)NIN * 1024 * 2, WO_UQ = WO_RETO + 1024 * 1024 * 2, WO_UKV = WO_UQ + 1536 * 256 * 2,
                 WO_MLAO = WO_UKV + 2048 * 128 * 2, WO_OUT = WO_MLAO + 1024 * 1024 * 2, WO_UP = WO_OUT + 1024 * 1024 * 2, WO_DOWN = WO_UP + (size_t)NUP * 1024 * 2,
                 W_LAYER = WO_DOWN + (size_t)1024 * DFF * 2;
static_assert(W_LAYER * 4 <= 139 * MiB, "weights");
constexpr size_t WS_H = 145 * MiB, WS_QR = 177 * MiB, WS_KR = 193 * MiB, WS_VR = 209 * MiB, WS_GR = 241 * MiB, WS_DQ = 273 * MiB, WS_DKV = 281 * MiB, WS_KROPE = 285 * MiB,
                 WS_GA = 288 * MiB, WS_GB = 320 * MiB, WS_QN = 352 * MiB, WS_QRP = 384 * MiB, WS_KN = 400 * MiB, WS_VM = 432 * MiB, WS_RO = 464 * MiB, WS_END = 496 * MiB;
constexpr size_t WS_AO = WS_QN, WS_MG = WS_VR, WS_AB = 177 * MiB, WS_U = 353 * MiB;
static_assert(WS_AB + (size_t)T * NUP * 2 <= WS_U && WS_U + (size_t)T * DFF * 2 <= WS_END, "ffn overlay");
constexpr int LDS_BYTES = 147456;

__device__ __forceinline__ unsigned cvtpk(float lo, float hi) { unsigned r; asm volatile("v_cvt_pk_bf16_f32 %0, %1, %2" : "=v"(r) : "v"(lo), "v"(hi)); return r; }
__device__ __forceinline__ float bf2f(unsigned short b) { return __uint_as_float((unsigned)b << 16); }
__device__ __forceinline__ float bflo(unsigned w) { return __uint_as_float(w << 16); }
__device__ __forceinline__ float bfhi(unsigned w) { return __uint_as_float(w & 0xffff0000u); }
__device__ __forceinline__ float sigmoidf_(float x) { return 1.0f / (1.0f + __expf(-x)); }
__device__ __forceinline__ u32x4 pack8(const f32x4 a, const f32x4 b) { u32x4 w; w.x = cvtpk(a[0], a[1]); w.y = cvtpk(a[2], a[3]); w.z = cvtpk(b[0], b[1]); w.w = cvtpk(b[2], b[3]); return w; }
__device__ __forceinline__ void unpack8(const u32x4 w, f32x4& a, f32x4& b) { a = (f32x4){bflo(w.x), bfhi(w.x), bflo(w.y), bfhi(w.y)}; b = (f32x4){bflo(w.z), bfhi(w.z), bflo(w.w), bfhi(w.w)}; }
__device__ __forceinline__ float wave_sum(float v) {
#pragma unroll
    for (int o = 1; o < 64; o <<= 1) v += __shfl_xor(v, o);
    return v;
}
__device__ __forceinline__ void rope8(f32x4& v0, f32x4& v1, const f32x4 c, const f32x4 s) {
    float a, b;
    a = v0[0]; b = v0[1]; v0[0] = a * c[0] - b * s[0]; v0[1] = b * c[0] + a * s[0];
    a = v0[2]; b = v0[3]; v0[2] = a * c[1] - b * s[1]; v0[3] = b * c[1] + a * s[1];
    a = v1[0]; b = v1[1]; v1[0] = a * c[2] - b * s[2]; v1[1] = b * c[2] + a * s[2];
    a = v1[2]; b = v1[3]; v1[2] = a * c[3] - b * s[3]; v1[3] = b * c[3] + a * s[3];
}

struct EpiCommon { static constexpr bool PERM = true, AFTER_DRAIN = false; };

struct EpiIn : EpiCommon {
    unsigned char* ws;
    __device__ __forceinline__ void operator()(const f32x4 (&acc)[2][2][4][2], const Unit& u, int wr, int wc, int fr, int fq) const {
        const int pn = u.pn, cw = wc * 32 + 8 * fq;
        unsigned char* ws = this->ws; asm volatile("" : "+s"(ws));
        const float* cosR = (const float*)(ws + WS_COSR); const float* sinR = (const float*)(ws + WS_SINR);
        const float* cosM = (const float*)(ws + WS_COSM); const float* sinM = (const float*)(ws + WS_SINM);
#pragma unroll
        for (int ai = 0; ai < 2; ++ai)
#pragma unroll
            for (int m = 0; m < 4; ++m) {
                const int r = u.pm * 256 + ai * 128 + wr * 64 + m * 16 + fr, pos = r & (SEQ - 1);
                if (pn < 4) {
                    bf16_t* dst = (bf16_t*)(ws + (pn < 2 ? WS_QR : WS_KR)) + (size_t)r * 512 + (pn & 1) * 256 + cw;
                    const float sc = pn < 2 ? 1.0f : RKSCALE;
                    const f32x4 c = *(const f32x4*)(cosR + pos * 64 + (cw >> 1)), s = *(const f32x4*)(sinR + pos * 64 + (cw >> 1));
#pragma unroll
                    for (int bj = 0; bj < 2; ++bj) { f32x4 v0 = acc[ai][bj][m][0], v1 = acc[ai][bj][m][1]; rope8(v0, v1, c, s); v0 = v0 * sc; v1 = v1 * sc; *(u32x4*)(dst + bj * 128) = pack8(v0, v1); }
                } else if (pn < 8) {
                    bf16_t* dst = (bf16_t*)(ws + WS_VR) + (size_t)r * 1024 + (pn - 4) * 256 + cw;
#pragma unroll
                    for (int bj = 0; bj < 2; ++bj) *(u32x4*)(dst + bj * 128) = pack8(acc[ai][bj][m][0], acc[ai][bj][m][1]);
                } else if (pn < 12) {
                    bf16_t* dst = (bf16_t*)(ws + WS_GR) + (size_t)r * 1024 + (pn - 8) * 256 + cw;
#pragma unroll
                    for (int bj = 0; bj < 2; ++bj) { f32x4 v0 = acc[ai][bj][m][0], v1 = acc[ai][bj][m][1];
#pragma unroll
                        for (int e = 0; e < 4; ++e) { v0[e] = v0[e] * sigmoidf_(v0[e]); v1[e] = v1[e] * sigmoidf_(v1[e]); }
                        *(u32x4*)(dst + bj * 128) = pack8(v0, v1); }
                } else if (pn == 12) {
                    bf16_t* dst = (bf16_t*)(ws + WS_DQ) + (size_t)r * 256 + cw; float ss = 0.f;
#pragma unroll
                    for (int bj = 0; bj < 2; ++bj) { const f32x4 v0 = acc[ai][bj][m][0], v1 = acc[ai][bj][m][1];
                        ss += (v0[0] * v0[0] + v0[1] * v0[1]) + (v0[2] * v0[2] + v0[3] * v0[3]) + (v1[0] * v1[0] + v1[1] * v1[1]) + (v1[2] * v1[2] + v1[3] * v1[3]);
                        *(u32x4*)(dst + bj * 128) = pack8(v0, v1); }
                    ss += __shfl_xor(ss, 16); ss += __shfl_xor(ss, 32);
                    if (fq == 0) ((float*)(ws + WS_SSQQ))[(size_t)r * 4 + wc] = ss;
                } else if (pn == 13) {
                    { const f32x4 v0 = acc[ai][0][m][0], v1 = acc[ai][0][m][1];
                      float ss = (v0[0] * v0[0] + v0[1] * v0[1]) + (v0[2] * v0[2] + v0[3] * v0[3]) + (v1[0] * v1[0] + v1[1] * v1[1]) + (v1[2] * v1[2] + v1[3] * v1[3]);
                      *(u32x4*)((bf16_t*)(ws + WS_DKV) + (size_t)r * 128 + cw) = pack8(v0, v1);
                      ss += __shfl_xor(ss, 16); ss += __shfl_xor(ss, 32);
                      if (fq == 0) ((float*)(ws + WS_SSQKV))[(size_t)r * 4 + wc] = ss; }
                    if (wc < 2) { f32x4 v0 = acc[ai][1][m][0], v1 = acc[ai][1][m][1];
                      const f32x4 c = *(const f32x4*)(cosM + pos * 32 + (cw >> 1)), s = *(const f32x4*)(sinM + pos * 32 + (cw >> 1));
                      rope8(v0, v1, c, s); *(u32x4*)((bf16_t*)(ws + WS_KROPE) + (size_t)r * 64 + cw) = pack8(v0, v1); }
                } else {
                    bf16_t* dst = (bf16_t*)(ws + (pn < 18 ? WS_GA : WS_GB)) + (size_t)r * 1024 + ((pn - 14) & 3) * 256 + cw;
#pragma unroll
                    for (int bj = 0; bj < 2; ++bj) { f32x4 v0 = acc[ai][bj][m][0], v1 = acc[ai][bj][m][1];
#pragma unroll
                        for (int e = 0; e < 4; ++e) { v0[e] = sigmoidf_(v0[e]); v1[e] = sigmoidf_(v1[e]); }
                        *(u32x4*)(dst + bj * 128) = pack8(v0, v1); }
                }
                asm volatile("" ::: "memory");
            }
    }
};
struct EpiUQ : EpiCommon {
    unsigned char* ws;
    __device__ __forceinline__ void operator()(const f32x4 (&acc)[2][2][4][2], const Unit& u, int wr, int wc, int fr, int fq) const {
        const int pn = u.pn, cw = wc * 32 + 8 * fq;
        unsigned char* ws = this->ws; asm volatile("" : "+s"(ws));
        const float* cosM = (const float*)(ws + WS_COSM); const float* sinM = (const float*)(ws + WS_SINM);
#pragma unroll
        for (int ai = 0; ai < 2; ++ai)
#pragma unroll
            for (int m = 0; m < 4; ++m) {
                const int r = u.pm * 256 + ai * 128 + wr * 64 + m * 16 + fr, pos = r & (SEQ - 1);
                const f32x4 q4 = *(const f32x4*)((const float*)(ws + WS_SSQQ) + (size_t)r * 4);
                const float rs = rsqrtf(((q4[0] + q4[1]) + (q4[2] + q4[3])) * (1.0f / 256.0f) + RMS_EPS) * QSCALE;
                if (pn < 4) {
                    bf16_t* dst = (bf16_t*)(ws + WS_QN) + (size_t)r * 1024 + pn * 256 + cw;
#pragma unroll
                    for (int bj = 0; bj < 2; ++bj) *(u32x4*)(dst + bj * 128) = pack8(acc[ai][bj][m][0] * rs, acc[ai][bj][m][1] * rs);
                } else {
                    bf16_t* dst = (bf16_t*)(ws + WS_QRP) + (size_t)r * 512 + (pn - 4) * 256 + cw;
                    const int i0 = ((wc & 1) * 32 + 8 * fq) >> 1;
                    const f32x4 c = *(const f32x4*)(cosM + pos * 32 + i0), s = *(const f32x4*)(sinM + pos * 32 + i0);
#pragma unroll
                    for (int bj = 0; bj < 2; ++bj) { f32x4 v0 = acc[ai][bj][m][0], v1 = acc[ai][bj][m][1]; rope8(v0, v1, c, s); *(u32x4*)(dst + bj * 128) = pack8(v0 * rs, v1 * rs); }
                }
                asm volatile("" ::: "memory");
            }
    }
};
struct EpiUKV : EpiCommon {
    unsigned char* ws;
    __device__ __forceinline__ void operator()(const f32x4 (&acc)[2][2][4][2], const Unit& u, int wr, int wc, int fr, int fq) const {
        const int pn = u.pn, cw = wc * 32 + 8 * fq;
        unsigned char* ws = this->ws; asm volatile("" : "+s"(ws));
#pragma unroll
        for (int ai = 0; ai < 2; ++ai)
#pragma unroll
            for (int m = 0; m < 4; ++m) {
                const int r = u.pm * 256 + ai * 128 + wr * 64 + m * 16 + fr;
                const f32x4 q4 = *(const f32x4*)((const float*)(ws + WS_SSQKV) + (size_t)r * 4);
                const float rs = rsqrtf(((q4[0] + q4[1]) + (q4[2] + q4[3])) * (1.0f / 128.0f) + RMS_EPS);
                bf16_t* dst = (bf16_t*)(ws + (pn < 4 ? WS_KN : WS_VM)) + (size_t)r * 1024 + (pn & 3) * 256 + cw;
#pragma unroll
                for (int bj = 0; bj < 2; ++bj) *(u32x4*)(dst + bj * 128) = pack8(acc[ai][bj][m][0] * rs, acc[ai][bj][m][1] * rs);
                asm volatile("" ::: "memory");
            }
    }
};
template <bool FIRST> struct EpiMerge : EpiCommon {
    unsigned char* ws;
    __device__ __forceinline__ void operator()(const f32x4 (&acc)[2][2][4][2], const Unit& u, int wr, int wc, int fr, int fq) const {
        const int cw = u.pn * 256 + wc * 32 + 8 * fq;
        unsigned char* ws = this->ws; asm volatile("" : "+s"(ws));
#pragma unroll
        for (int ai = 0; ai < 2; ++ai)
#pragma unroll
            for (int m = 0; m < 4; ++m) {
                const size_t off = (size_t)(u.pm * 256 + ai * 128 + wr * 64 + m * 16 + fr) * 1024 + cw;
#pragma unroll
                for (int bj = 0; bj < 2; ++bj) {
                    f32x4 g0, g1; unpack8(*(const u32x4*)((const bf16_t*)(ws + (FIRST ? WS_GA : WS_GB)) + off + bj * 128), g0, g1);
                    f32x4 v0 = acc[ai][bj][m][0] * g0, v1 = acc[ai][bj][m][1] * g1;
                    bf16_t* dst = (bf16_t*)(ws + WS_MG) + off + bj * 128;
                    if (!FIRST) { f32x4 p0, p1; unpack8(*(const u32x4*)dst, p0, p1); v0 += p0; v1 += p1; }
                    *(u32x4*)dst = pack8(v0, v1);
                }
                asm volatile("" ::: "memory");
            }
    }
};
struct EpiRes : EpiCommon {
    float* x; const float* gate;
    __device__ __forceinline__ void operator()(const f32x4 (&acc)[2][2][4][2], const Unit& u, int wr, int wc, int fr, int fq) const {
        const int cw = u.pn * 256 + wc * 32 + 8 * fq;
        float* x = this->x; const float* gate = this->gate; asm volatile("" : "+s"(x), "+s"(gate));
        const float* gp = gate + (size_t)(u.pm >> 3) * 6144 + cw;
        f32x4 gg[2][2];
#pragma unroll
        for (int bj = 0; bj < 2; ++bj)
#pragma unroll
            for (int n = 0; n < 2; ++n) gg[bj][n] = *(const f32x4*)(gp + bj * 128 + 4 * n) + 1.0f;
#pragma unroll
        for (int ai = 0; ai < 2; ++ai)
#pragma unroll
            for (int m = 0; m < 4; ++m) {
                float* xp = x + (size_t)(u.pm * 256 + ai * 128 + wr * 64 + m * 16 + fr) * 1024 + cw;
#pragma unroll
                for (int bj = 0; bj < 2; ++bj)
#pragma unroll
                    for (int n = 0; n < 2; ++n) { f32x4* q = (f32x4*)(xp + bj * 128 + 4 * n); *q = *q * ALPHA + gg[bj][n] * acc[ai][bj][m][n]; }
                asm volatile("" ::: "memory");
            }
    }
};
struct EpiUp : EpiCommon {
    unsigned char* ws;
    __device__ __forceinline__ void operator()(const f32x4 (&acc)[2][2][4][2], const Unit& u, int wr, int wc, int fr, int fq) const {
        const int cw = u.pn * 256 + wc * 32 + 8 * fq;
        unsigned char* ws = this->ws; asm volatile("" : "+s"(ws));
#pragma unroll
        for (int ai = 0; ai < 2; ++ai)
#pragma unroll
            for (int m = 0; m < 4; ++m) {
                bf16_t* dst = (bf16_t*)(ws + WS_AB) + (size_t)(u.pm * 256 + ai * 128 + wr * 64 + m * 16 + fr) * NUP + cw;
#pragma unroll
                for (int bj = 0; bj < 2; ++bj) *(u32x4*)(dst + bj * 128) = pack8(acc[ai][bj][m][0], acc[ai][bj][m][1]);
            }
    }
};
#define SBAR() __builtin_amdgcn_sched_barrier(0)
__device__ __forceinline__ int crow(int r, int hi) { return (r & 3) + 8 * (r >> 2) + 4 * hi; }
__device__ __forceinline__ int v_st(int k, int c) { const int kk = (k & ~0xC) | ((k & 4) << 1) | ((k & 8) >> 1); return ((kk >> 3) * 4 + (c >> 5)) * 512 + ((kk & 7) * 32 + (c & 31)) * 2; }
__device__ __forceinline__ int v_rd_base(int lane) { return ((lane & 3) << 3) | (((lane >> 2) & 3) << 6) | (((lane >> 4) & 1) << 5) | (((lane >> 5) & 1) << 8); }
constexpr int v_rd_off(int d0, int ks, int half) { return d0 * 512 + ks * 4096 + half * 2048; }
template <int OFF> __device__ __forceinline__ s16x4 tr_read(int vb) {
    s16x4 r; asm volatile("ds_read_b64_tr_b16 %0, %1 offset:%2" : "=&v"(r) : "v"(vb), "i"(OFF) : "memory"); return r;
}
template <int D0> __device__ __forceinline__ void pv_one(f32x16& od, int vb, bf16x8 pa0, bf16x8 pa1, bf16x8 pa2, bf16x8 pa3) {
    const s16x4 l0 = tr_read<v_rd_off(D0, 0, 0)>(vb), h0 = tr_read<v_rd_off(D0, 0, 1)>(vb), l1 = tr_read<v_rd_off(D0, 1, 0)>(vb), h1 = tr_read<v_rd_off(D0, 1, 1)>(vb);
    const s16x4 l2 = tr_read<v_rd_off(D0, 2, 0)>(vb), h2 = tr_read<v_rd_off(D0, 2, 1)>(vb), l3 = tr_read<v_rd_off(D0, 3, 0)>(vb), h3 = tr_read<v_rd_off(D0, 3, 1)>(vb);
    asm volatile("s_waitcnt lgkmcnt(0)" ::: "memory"); SBAR();
#define PK(L, H) (bf16x8){L[0], L[1], L[2], L[3], H[0], H[1], H[2], H[3]}
    od = __builtin_amdgcn_mfma_f32_32x32x16_bf16(pa0, PK(l0, h0), od, 0, 0, 0);
    od = __builtin_amdgcn_mfma_f32_32x32x16_bf16(pa1, PK(l1, h1), od, 0, 0, 0);
    od = __builtin_amdgcn_mfma_f32_32x32x16_bf16(pa2, PK(l2, h2), od, 0, 0, 0);
    od = __builtin_amdgcn_mfma_f32_32x32x16_bf16(pa3, PK(l3, h3), od, 0, 0, 0);
#undef PK
}
__device__ __forceinline__ void pv_d0(f32x16* o, int vb, bf16x8 pa0, bf16x8 pa1, bf16x8 pa2, bf16x8 pa3) {
    pv_one<0>(o[0], vb, pa0, pa1, pa2, pa3); pv_one<1>(o[1], vb, pa0, pa1, pa2, pa3); pv_one<2>(o[2], vb, pa0, pa1, pa2, pa3); pv_one<3>(o[3], vb, pa0, pa1, pa2, pa3);
}
__device__ __forceinline__ void pack_p(const f32x16& p0, const f32x16& p1, bf16x8& pa0, bf16x8& pa1, bf16x8& pa2, bf16x8& pa3) {
#define PK4(P, BASE, OUT) do { unsigned a0 = cvtpk(P[BASE + 0], P[BASE + 1]), a1 = cvtpk(P[BASE + 2], P[BASE + 3]);   \
    unsigned b0 = cvtpk(P[BASE + 4], P[BASE + 5]), b1 = cvtpk(P[BASE + 6], P[BASE + 7]);                              \
    auto r0 = __builtin_amdgcn_permlane32_swap(a0, b0, false, false); auto r1 = __builtin_amdgcn_permlane32_swap(a1, b1, false, false); \
    u32x4 w = {r0[0], r1[0], r0[1], r1[1]}; OUT = *reinterpret_cast<bf16x8*>(&w); } while (0)
    PK4(p0, 0, pa0); PK4(p0, 8, pa1); PK4(p1, 0, pa2); PK4(p1, 8, pa3);
#undef PK4
}
constexpr float FA_THR = 11.5f;
__device__ __forceinline__ void partialSM(f32x16& p0, f32x16& p1, float& m_reg, float& alpha) {
    float pmax = p0[0];
#pragma unroll
    for (int r = 1; r < 16; ++r) pmax = fmaxf(pmax, p0[r]);
#pragma unroll
    for (int r = 0; r < 16; ++r) pmax = fmaxf(pmax, p1[r]);
    { auto rr = __builtin_amdgcn_permlane32_swap(__float_as_uint(pmax), __float_as_uint(pmax), false, false);
      pmax = fmaxf(__uint_as_float(rr[0]), __uint_as_float(rr[1])); }
    float mn;
    if (__builtin_expect(__all(pmax - m_reg <= FA_THR), 1)) { mn = m_reg; alpha = 1.f; }
    else { mn = fmaxf(m_reg, pmax); alpha = __builtin_amdgcn_exp2f(m_reg - mn); m_reg = mn; }
#pragma unroll
    for (int r = 0; r < 16; ++r) p0[r] = p0[r] - mn;
#pragma unroll
    for (int r = 0; r < 16; ++r) p1[r] = p1[r] - mn;
#pragma unroll
    for (int r = 0; r < 16; ++r) p0[r] = __builtin_amdgcn_exp2f(p0[r]);
}
__device__ __forceinline__ void finishSM(f32x16& p0, f32x16& p1, float alpha, float& l_reg, bf16x8& pa0, bf16x8& pa1, bf16x8& pa2, bf16x8& pa3) {
#pragma unroll
    for (int r = 0; r < 16; ++r) p1[r] = __builtin_amdgcn_exp2f(p1[r]);
    float ps = 0;
#pragma unroll
    for (int r = 0; r < 16; ++r) ps += p0[r];
#pragma unroll
    for (int r = 0; r < 16; ++r) ps += p1[r];
    { auto rr = __builtin_amdgcn_permlane32_swap(__float_as_uint(ps), __float_as_uint(ps), false, false);
      ps = __uint_as_float(rr[0]) + __uint_as_float(rr[1]); }
    l_reg = l_reg * alpha + ps;
    pack_p(p0, p1, pa0, pa1, pa2, pa3);
}
template <int HALF> __device__ __forceinline__ void decay_half(f32x16& p, float dbase, float lf2, float nlb2) {
#pragma unroll
    for (int r = 0; r < 16; ++r) { const float d = dbase - (float)((r & 3) + 8 * (r >> 2) + 32 * HALF); const float e = d * (d >= 0.f ? lf2 : nlb2); p[r] *= __builtin_amdgcn_exp2f(e); }
}

struct FaArgs {
    const bf16_t* Q1; const bf16_t* Q2; const bf16_t* K1; const bf16_t* K2; const bf16_t* V; bf16_t* O;
    int q0; float lf2, nlb2;
};
template <int MODE> __device__ __forceinline__ void flash_unit(const FaArgs& A, char* lds, const int wv_) {
    constexpr int ND0 = MODE == 0 ? 12 : 8, KROW = ND0 * 32, SHM_V = 64 * 256, SHM_K = 64 * KROW, SDEPTH = 1, NLD = MODE == 0 ? 5 : 4;
    constexpr int LDQ1 = MODE == 0 ? 1024 : 512, LDQ2 = 512, LDK1 = MODE == 0 ? 1024 : 512, LDK2 = 64, LDV = 1024, LDO = 1024;
    int tid; asm volatile("v_mbcnt_lo_u32_b32 %0, -1, 0\n\tv_mbcnt_hi_u32_b32 %0, -1, %0" : "=v"(tid)); tid += wv_ * 64; const int wid = tid >> 6, lane = tid & 63, r32 = lane & 31, hi = lane >> 5;
    char* V_lds = lds; char* K_lds = lds + 2 * SHM_V;
    float* wsf = (float*)(lds + 2 * SHM_V + 2 * SHM_K) + wid * 64; float* li_l = wsf; float* al_l = wsf + 32;
#define KSWZ(row, colB) ((row) * KROW + ((colB) ^ (((row) & 7) << 4)))
    float m_reg = -1e30f, l_reg = 0.f; f32x16 o[4] = {}; bf16x8 qr[8];
    char* qs = lds + 2 * SHM_V + 2 * SHM_K + 2048 + tid * 16;
    {
        const long qrow = A.q0 + wid * 32 + r32;
        const bf16_t* Qw = A.Q1 + qrow * LDQ1 + hi * 8;
#pragma unroll
        for (int d0 = 0; d0 < 8; ++d0) qr[d0] = *reinterpret_cast<const bf16x8*>(Qw + d0 * 16);
        if constexpr (MODE == 0) {
            const bf16_t* Qw2 = A.Q2 + qrow * LDQ2 + hi * 8;
#pragma unroll
            for (int d0 = 0; d0 < 4; ++d0) *reinterpret_cast<bf16x8*>(qs + d0 * 8192) = *reinterpret_cast<const bf16x8*>(Qw2 + d0 * 16);
        }
    }
    const int sr = tid >> 4, sc = (tid & 15) * 8, vst0 = v_st(sr, sc), vst1 = v_st(32 + sr, sc);
    const int sr2 = tid >> 3, sc2 = (tid & 7) * 8;
    const int vb0 = (int)(uintptr_t)V_lds + v_rd_base(lane);
    struct { bf16x8 vs0, vs1, ks0, ks1, kr; } st_[SDEPTH];
#define SLOAD(i, k0) do { st_[i].vs0 = *(const bf16x8*)(A.V + (long)((k0) + sr) * LDV + sc); st_[i].vs1 = *(const bf16x8*)(A.V + (long)((k0) + 32 + sr) * LDV + sc); \
    st_[i].ks0 = *(const bf16x8*)(A.K1 + (long)((k0) + sr) * LDK1 + sc); st_[i].ks1 = *(const bf16x8*)(A.K1 + (long)((k0) + 32 + sr) * LDK1 + sc); \
    if constexpr (MODE == 0) st_[i].kr = *(const bf16x8*)(A.K2 + (long)((k0) + sr2) * LDK2 + sc2); } while (0)
#define SWRITE(b, i) do { *(bf16x8*)(V_lds + (b) * SHM_V + vst0) = st_[i].vs0; *(bf16x8*)(V_lds + (b) * SHM_V + vst1) = st_[i].vs1; \
    *(bf16x8*)(K_lds + (b) * SHM_K + KSWZ(sr, sc * 2)) = st_[i].ks0; *(bf16x8*)(K_lds + (b) * SHM_K + KSWZ(32 + sr, sc * 2)) = st_[i].ks1; \
    if constexpr (MODE == 0) *(bf16x8*)(K_lds + (b) * SHM_K + KSWZ(sr2, 256 + sc2 * 2)) = st_[i].kr; } while (0)
#define SWAIT() do { if constexpr (SDEPTH == 2) { if constexpr (NLD == 5) asm volatile("s_waitcnt vmcnt(5)" ::: "memory"); else asm volatile("s_waitcnt vmcnt(4)" ::: "memory"); } \
    else asm volatile("s_waitcnt vmcnt(0)" ::: "memory"); } while (0)
#define RESC(a) do { if constexpr (MODE == 0) { if (__any((a) < 1.f)) { if (hi == 0) al_l[r32] = (a); asm volatile("s_waitcnt lgkmcnt(0)" ::: "memory"); \
    _Pragma("unroll") for (int d = 0; d < 4; ++d) _Pragma("unroll") for (int r = 0; r < 16; ++r) o[d][r] *= al_l[crow(r, hi)]; } } } while (0)
#define QKT(P0, P1, KB) do { P0 = f32x16{}; P1 = f32x16{}; \
    _Pragma("unroll") for (int d0 = 0; d0 < 8; ++d0) { const int cb = (d0 * 16 + hi * 8) * 2; \
      const bf16x8 b0 = *reinterpret_cast<const bf16x8*>((KB) + KSWZ(r32, cb)); const bf16x8 b1 = *reinterpret_cast<const bf16x8*>((KB) + KSWZ(32 + r32, cb)); \
      P0 = __builtin_amdgcn_mfma_f32_32x32x16_bf16(b0, qr[d0], P0, 0, 0, 0); P1 = __builtin_amdgcn_mfma_f32_32x32x16_bf16(b1, qr[d0], P1, 0, 0, 0); } \
    if constexpr (MODE == 0) { _Pragma("unroll") for (int d0 = 0; d0 < 4; ++d0) { const int cb = ((8 + d0) * 16 + hi * 8) * 2; const bf16x8 qx = *reinterpret_cast<const bf16x8*>(qs + d0 * 8192); \
      const bf16x8 b0 = *reinterpret_cast<const bf16x8*>((KB) + KSWZ(r32, cb)); const bf16x8 b1 = *reinterpret_cast<const bf16x8*>((KB) + KSWZ(32 + r32, cb)); \
      P0 = __builtin_amdgcn_mfma_f32_32x32x16_bf16(b0, qx, P0, 0, 0, 0); P1 = __builtin_amdgcn_mfma_f32_32x32x16_bf16(b1, qx, P1, 0, 0, 0); } } } while (0)
    const float tq = (float)(A.q0 + wid * 32 + r32 - 4 * hi);
#define PARTIAL(P0, P1, AL, J) do { if constexpr (MODE == 0) partialSM(P0, P1, m_reg, AL); else decay_half<0>(P0, tq - (float)((J) * 64), A.lf2, A.nlb2); } while (0)
#define FINISH(P0, P1, AL, J) do { if constexpr (MODE == 0) finishSM(P0, P1, AL, l_reg, pa0, pa1, pa2, pa3); else { decay_half<1>(P1, tq - (float)((J) * 64), A.lf2, A.nlb2); pack_p(P0, P1, pa0, pa1, pa2, pa3); } } while (0)
    f32x16 pA0, pA1, pB0, pB1; float alA = 1.f, alB = 1.f; bf16x8 pa0, pa1, pa2, pa3; constexpr int NT = SEQ / 64;
    constexpr int SE = 0, SO = SDEPTH - 1;
    SLOAD(SE, 0); asm volatile("s_waitcnt vmcnt(0)" ::: "memory"); SWRITE(0, SE); __syncthreads();
    QKT(pA0, pA1, K_lds); PARTIAL(pA0, pA1, alA, 0);
    SLOAD(SO, 64); if constexpr (SDEPTH == 2) { SLOAD(SE, 128); }
    SWAIT(); SWRITE(1, SO); __syncthreads();
    for (int j = 1; j + 1 < NT; j += 2) {
        SBAR(); QKT(pB0, pB1, K_lds + SHM_K);
        FINISH(pA0, pA1, alA, j - 1); SBAR();
        SLOAD(SO, (j + SDEPTH) * 64); SBAR();
        pv_d0(o, vb0, pa0, pa1, pa2, pa3); PARTIAL(pB0, pB1, alB, j);
        __syncthreads(); SWAIT(); SWRITE(0, SE);
        RESC(alB); __syncthreads();
        SBAR(); QKT(pA0, pA1, K_lds);
        FINISH(pB0, pB1, alB, j); SBAR();
        if (SDEPTH == 1 || j + 3 < NT) SLOAD(SE, (j + 1 + SDEPTH) * 64); SBAR();
        pv_d0(o, vb0 + SHM_V, pa0, pa1, pa2, pa3); PARTIAL(pA0, pA1, alA, j + 1);
        __syncthreads(); SWAIT(); SWRITE(1, SO);
        RESC(alA); __syncthreads();
    }
    SBAR(); QKT(pB0, pB1, K_lds + SHM_K);
    FINISH(pA0, pA1, alA, NT - 2); SBAR();
    pv_d0(o, vb0, pa0, pa1, pa2, pa3); PARTIAL(pB0, pB1, alB, NT - 1);
    __syncthreads(); RESC(alB);
    FINISH(pB0, pB1, alB, NT - 1); SBAR();
    pv_d0(o, vb0 + SHM_V, pa0, pa1, pa2, pa3);
    float rli[16];
    if constexpr (MODE == 0) {
        if (hi == 0) li_l[r32] = l_reg; asm volatile("s_waitcnt lgkmcnt(0)" ::: "memory");
#pragma unroll
        for (int r = 0; r < 16; ++r) rli[r] = __builtin_amdgcn_rcpf(li_l[crow(r, hi)]);
    } else {
#pragma unroll
        for (int r = 0; r < 16; ++r) rli[r] = 1.f;
    }
    bf16_t* Ow = A.O + (long)(A.q0 + wid * 32) * LDO;
#pragma unroll
    for (int r = 0; r < 16; ++r) { const int orow = crow(r, hi);
#pragma unroll
        for (int d0 = 0; d0 < 4; ++d0) { const float v = o[d0][r] * rli[r]; Ow[(long)orow * LDO + d0 * 32 + r32] = (bf16_t)(cvtpk(v, v) & 0xffffu); } }
    __syncthreads();
#undef KSWZ
#undef SLOAD
#undef SWRITE
#undef SWAIT
#undef RESC
#undef QKT
#undef PARTIAL
#undef FINISH
}
__device__ __forceinline__ int map_col(int id, int n) {
    if (id == 0) {
        if (n < 1024) { const int j = n & 127; return (n & ~127) + (j & 1) * 64 + (j >> 1); }
        if (n < 3456) return n;
        if (n < 3520) { const int j = n - 3456; return 3456 + (j & 1) * 32 + (j >> 1); }
        if (n < 3584) return -1;
        return n - 64;
    }
    if (id == 2) {
        if (n < 1024) return (n >> 7) * 192 + (n & 127);
        const int j = n - 1024, h = j >> 6, jj = j & 63; return h * 192 + 128 + (jj & 1) * 32 + (jj >> 1);
    }
    return n;
}
__device__ __forceinline__ void transpose_item(const float* W, int K, int Nsrc, bf16_t* WT, int row_off, int nblk, int mapid, const float* rowscale, LAS float* scr, int item, int lane) {
    const int kb = item / nblk, nb = item % nblk, k0 = 64 * kb, n0 = 32 * nb;
    const int sc = map_col(mapid, n0 + (lane & 31));
#pragma unroll 8
    for (int i = 0; i < 32; ++i) { const int kk = 2 * i + (lane >> 5); float v = sc >= 0 ? W[(size_t)(k0 + kk) * Nsrc + sc] : 0.f; if (rowscale) v *= rowscale[k0 + kk]; scr[kk * 33 + (lane & 31)] = v; }
    asm volatile("s_waitcnt lgkmcnt(0)" ::: "memory");
    const int c = lane & 7;
#pragma unroll
    for (int j = 0; j < 4; ++j) { const int n = (lane >> 3) + 8 * j; const LAS float* s = scr + (8 * c) * 33 + n;
        u32x4 o; o.x = cvtpk(s[0 * 33], s[1 * 33]); o.y = cvtpk(s[2 * 33], s[3 * 33]); o.z = cvtpk(s[4 * 33], s[5 * 33]); o.w = cvtpk(s[6 * 33], s[7 * 33]);
        *(u32x4*)(WT + (size_t)(row_off + n0 + n) * K + k0 + 8 * c) = o; }
    asm volatile("s_waitcnt lgkmcnt(0)" ::: "memory");
}
struct KP { const float* in[N_INPUTS]; float* out; unsigned char* ws; int lo, hi; };

__device__ __forceinline__ void prologue(const KP& p, unsigned char* lds, const int wv_) {
    int tid; asm volatile("v_mbcnt_lo_u32_b32 %0, -1, 0\n\tv_mbcnt_hi_u32_b32 %0, -1, %0" : "=v"(tid)); tid += wv_ * 64; int Gd = gridDim.x, cb_ = blockIdx.x; asm volatile("" : "+s"(Gd), "+s"(cb_)); const int lane = tid & 63, wave = tid >> 6, G = Gd;
    float* sl = (float*)lds;
    float* red = (float*)(lds + 98304);
    for (int u = cb_; u < DEPTH * 48; u += G) {
        const int l = u / 48, cb = u % 48;
        for (int i = tid; i < NBATCH * DM; i += 512) { const int b = i >> 10, k = i & 1023; const float c = b < 16 ? p.in[I_CP][b * DM + k] : p.in[I_CS][(b - 16) * DM + k]; sl[i] = c * sigmoidf_(c); }
        __syncthreads();
        const int col = cb * 128 + (tid & 127), kq = tid >> 7;
        const float* W = p.in[I_WADA] + (size_t)l * DM * 6144 + (size_t)(kq * 256) * 6144 + col;
        float acc[NBATCH];
#pragma unroll
        for (int b = 0; b < NBATCH; ++b) acc[b] = 0.f;
        for (int k = 0; k < 256; ++k) { const float w = W[(size_t)k * 6144];
#pragma unroll
            for (int b = 0; b < NBATCH; ++b) acc[b] = fmaf(sl[b * DM + kq * 256 + k], w, acc[b]); }
        if (kq > 0) {
#pragma unroll
            for (int b = 0; b < NBATCH; ++b) red[((kq - 1) * NBATCH + b) * 128 + (tid & 127)] = acc[b];
        }
        __syncthreads();
        if (kq == 0) { float* ada = (float*)(p.ws + WS_ADA) + (size_t)l * NBATCH * 6144; const float bias = p.in[I_BADA][l * 6144 + col];
#pragma unroll
            for (int b = 0; b < NBATCH; ++b) ada[(size_t)b * 6144 + col] = acc[b] + red[(0 * NBATCH + b) * 128 + tid] + red[(1 * NBATCH + b) * 128 + tid] + red[(2 * NBATCH + b) * 128 + tid] + bias; }
        __syncthreads();
    }
    { float* cosR = (float*)(p.ws + WS_COSR); float* sinR = (float*)(p.ws + WS_SINR); float* cosM = (float*)(p.ws + WS_COSM); float* sinM = (float*)(p.ws + WS_SINM);
      for (int i = cb_ * 512 + tid; i < SEQ * 96; i += G * 512) {
          const int pos = i / 96, j = i % 96; const bool isr = j < 64; const int idx = isr ? j : j - 64;
          const float inv = isr ? exp2f(-13.287712379549449f * (float)idx * (1.0f / 64.0f)) : exp2f(-13.287712379549449f * (float)idx * (1.0f / 32.0f));
          const float ang = (float)pos * inv;
          const double tr = (double)ang * 0.15915494309189535; const double fr = tr - floor(tr);
          const float a2 = (float)(fr * 6.283185307179586);
          const float cs = cosf(a2), sn = sinf(a2);
          if (isr) { cosR[pos * 64 + idx] = cs; sinR[pos * 64 + idx] = sn; } else { cosM[pos * 32 + idx] = cs; sinM[pos * 32 + idx] = sn; }
      } }
    LAS float* scr = (LAS float*)((LAS unsigned char*)lds + wave * 16384);
    constexpr int IT_IN = 16 * 176, IT_SQ = 16 * 32, IT_UQ = 4 * 48, IT_UK = 2 * 32, IT_UP = 16 * 176, IT_DN = 44 * 32;
    constexpr int IT_LAYER = IT_IN + 3 * IT_SQ + IT_UQ + 2 * IT_UK + IT_UP + IT_DN;
    const int gw = cb_ * 8 + wave, NGW = G * 8;
    for (int it = gw; it < DEPTH * IT_LAYER; it += NGW) {
        const int l = it / IT_LAYER; int r = it % IT_LAYER; unsigned char* wl = p.ws + WS_W + (size_t)l * W_LAYER;
        if (r < IT_IN) { transpose_item(p.in[I_WIN] + (size_t)l * 1024 * 5568, 1024, 5568, (bf16_t*)(wl + WO_IN), 0, 176, 0, nullptr, scr, r, lane); continue; } r -= IT_IN;
        if (r < IT_SQ) { transpose_item(p.in[I_WRETO] + (size_t)l * 1024 * 1024, 1024, 1024, (bf16_t*)(wl + WO_RETO), 0, 32, 1, nullptr, scr, r, lane); continue; } r -= IT_SQ;
        if (r < IT_UQ) { transpose_item(p.in[I_WUQ] + (size_t)l * 256 * 1536, 256, 1536, (bf16_t*)(wl + WO_UQ), 0, 48, 2, p.in[I_QNG] + l * 256, scr, r, lane); continue; } r -= IT_UQ;
        if (r < IT_UK) { transpose_item(p.in[I_WUK] + (size_t)l * 128 * 1024, 128, 1024, (bf16_t*)(wl + WO_UKV), 0, 32, 1, p.in[I_KVNG] + l * 128, scr, r, lane); continue; } r -= IT_UK;
        if (r < IT_UK) { transpose_item(p.in[I_WUV] + (size_t)l * 128 * 1024, 128, 1024, (bf16_t*)(wl + WO_UKV), 1024, 32, 1, p.in[I_KVNG] + l * 128, scr, r, lane); continue; } r -= IT_UK;
        if (r < IT_SQ) { transpose_item(p.in[I_WMLAO] + (size_t)l * 1024 * 1024, 1024, 1024, (bf16_t*)(wl + WO_MLAO), 0, 32, 1, nullptr, scr, r, lane); continue; } r -= IT_SQ;
        if (r < IT_SQ) { transpose_item(p.in[I_WOUT] + (size_t)l * 1024 * 1024, 1024, 1024, (bf16_t*)(wl + WO_OUT), 0, 32, 1, nullptr, scr, r, lane); continue; } r -= IT_SQ;
        if (r < IT_UP) { transpose_item(p.in[I_WUP] + (size_t)l * 1024 * 5632, 1024, 5632, (bf16_t*)(wl + WO_UP), 0, 176, 1, nullptr, scr, r, lane); continue; } r -= IT_UP;
        transpose_item(p.in[I_WDOWN] + (size_t)l * 2816 * 1024, 2816, 1024, (bf16_t*)(wl + WO_DOWN), 0, 32, 1, nullptr, scr, r, lane);
    }
}

template <int MODE> __device__ __forceinline__ void row_phase(const KP& p, int g, const float* lng, const float* lnb, const int wv_, const float* mod  ) {
    int tid; asm volatile("v_mbcnt_lo_u32_b32 %0, -1, 0\n\tv_mbcnt_hi_u32_b32 %0, -1, %0" : "=v"(tid)); tid += wv_ * 64; int Gd = gridDim.x, cb_ = blockIdx.x; asm volatile("" : "+s"(Gd), "+s"(cb_)); const int lane = tid & 63, gw = cb_ * 8 + (tid >> 6), NGW = Gd * 8;
    bf16_t* H = (bf16_t*)(p.ws + WS_H);
    for (int r = gw; r < T; r += NGW) {
        const int gr = g * T + r, b = gr >> 11;
        float* xrow = p.out + (size_t)gr * DM;
        const float* src = MODE == 0 ? (gr < 16 * SEQ ? p.in[I_XP] + (size_t)gr * DM : p.in[I_XS] + (size_t)(gr - 16 * SEQ) * DM) : xrow;
        f32x4 v[4];
#pragma unroll
        for (int j = 0; j < 4; ++j) v[j] = *((const f32x4*)src + lane + 64 * j);
        if (MODE != 0) {
            float s = 0.f;
#pragma unroll
            for (int j = 0; j < 4; ++j) s += (v[j][0] + v[j][1]) + (v[j][2] + v[j][3]);
            const float mean = wave_sum(s) * (1.f / DM); float s2 = 0.f;
#pragma unroll
            for (int j = 0; j < 4; ++j) { v[j] = v[j] - mean; s2 += (v[j][0] * v[j][0] + v[j][1] * v[j][1]) + (v[j][2] * v[j][2] + v[j][3] * v[j][3]); }
            const float rstd = rsqrtf(wave_sum(s2) * (1.f / DM) + LN_EPS);
#pragma unroll
            for (int j = 0; j < 4; ++j) { const f32x4 gg = *((const f32x4*)lng + lane + 64 * j), bb = *((const f32x4*)lnb + lane + 64 * j); v[j] = v[j] * rstd * gg + bb; }
        }
#pragma unroll
        for (int j = 0; j < 4; ++j) *((f32x4*)xrow + lane + 64 * j) = v[j];
        if (mod) {
            float s = 0.f;
#pragma unroll
            for (int j = 0; j < 4; ++j) s += (v[j][0] + v[j][1]) + (v[j][2] + v[j][3]);
            const float mean = wave_sum(s) * (1.f / DM); float s2 = 0.f;
#pragma unroll
            for (int j = 0; j < 4; ++j) { v[j] = v[j] - mean; s2 += (v[j][0] * v[j][0] + v[j][1] * v[j][1]) + (v[j][2] * v[j][2] + v[j][3] * v[j][3]); }
            const float rstd = rsqrtf(wave_sum(s2) * (1.f / DM) + LN_EPS);
            const float* mb = mod + (size_t)b * 6144;
#pragma unroll
            for (int j = 0; j < 4; ++j) { const f32x4 sh = *((const f32x4*)mb + lane + 64 * j), sc = *((const f32x4*)(mb + 1024) + lane + 64 * j);
                const f32x4 h = v[j] * rstd * (sc + 1.0f) + sh;
                unsigned long long w = (unsigned long long)cvtpk(h[0], h[1]) | ((unsigned long long)cvtpk(h[2], h[3]) << 32);
                *((unsigned long long*)(H + (size_t)r * DM) + lane + 64 * j) = w; }
        }
    }
}
__device__ __forceinline__ void rogate_phase(const KP& p, const float* gn, const int wv_) {
    int tid; asm volatile("v_mbcnt_lo_u32_b32 %0, -1, 0\n\tv_mbcnt_hi_u32_b32 %0, -1, %0" : "=v"(tid)); tid += wv_ * 64; int Gd = gridDim.x, cb_ = blockIdx.x; asm volatile("" : "+s"(Gd), "+s"(cb_)); const int lane = tid & 63, gw = cb_ * 8 + (tid >> 6), NGW = Gd * 8;
    bf16_t* RO = (bf16_t*)(p.ws + WS_RO); const bf16_t* GR = (const bf16_t*)(p.ws + WS_GR);
    const int c0 = (lane >> 4) * 256 + (lane & 15) * 8;
    for (int r = gw; r < T; r += NGW) {
        f32x4 a[4];
        unpack8(*(const u32x4*)(RO + (size_t)r * 1024 + c0), a[0], a[1]); unpack8(*(const u32x4*)(RO + (size_t)r * 1024 + c0 + 128), a[2], a[3]);
        float s = 0.f;
#pragma unroll
        for (int j = 0; j < 4; ++j) s += (a[j][0] + a[j][1]) + (a[j][2] + a[j][3]);
        s += __shfl_xor(s, 1); s += __shfl_xor(s, 2); s += __shfl_xor(s, 4); s += __shfl_xor(s, 8);
        const float mean = s * (1.f / 256.f); float s2 = 0.f;
#pragma unroll
        for (int j = 0; j < 4; ++j) { a[j] = a[j] - mean; s2 += (a[j][0] * a[j][0] + a[j][1] * a[j][1]) + (a[j][2] * a[j][2] + a[j][3] * a[j][3]); }
        s2 += __shfl_xor(s2, 1); s2 += __shfl_xor(s2, 2); s2 += __shfl_xor(s2, 4); s2 += __shfl_xor(s2, 8);
        const float rstd = rsqrtf(s2 * (1.f / 256.f) + LN_EPS);
#pragma unroll
        for (int hh = 0; hh < 2; ++hh) {
            f32x4 g0, g1; unpack8(*(const u32x4*)(GR + (size_t)r * 1024 + c0 + hh * 128), g0, g1);
            const f32x4 w0 = *(const f32x4*)(gn + c0 + hh * 128), w1 = *(const f32x4*)(gn + c0 + hh * 128 + 4);
            *(u32x4*)(RO + (size_t)r * 1024 + c0 + hh * 128) = pack8(a[2 * hh] * rstd * w0 * g0, a[2 * hh + 1] * rstd * w1 * g1);
        }
    }
}
__device__ __forceinline__ void conv_phase(const KP& p, const float* cw, const float* cb, const int wv_) {
    const bf16_t* AB = (const bf16_t*)(p.ws + WS_AB); bf16_t* U = (bf16_t*)(p.ws + WS_U);
    constexpr int CH = DFF / 8;
    int tid; asm volatile("v_mbcnt_lo_u32_b32 %0, -1, 0\n\tv_mbcnt_hi_u32_b32 %0, -1, %0" : "=v"(tid)); tid += wv_ * 64; int Gd = gridDim.x, cb_ = blockIdx.x; asm volatile("" : "+s"(Gd), "+s"(cb_));
    for (int it = cb_ * 512 + tid; it < T * CH; it += Gd * 512) {
        const int r = it / CH, c = (it % CH) * 8, pos = r & (SEQ - 1);
        f32x4 a0, a1, t0, t1, acc0, acc1;
        { const f32x4 w0 = *(const f32x4*)(cw + DFF + c), w1 = *(const f32x4*)(cw + DFF + c + 4); unpack8(*(const u32x4*)(AB + (size_t)r * NUP + c), a0, a1);
          acc0 = a0 * w0 + *(const f32x4*)(cb + c); acc1 = a1 * w1 + *(const f32x4*)(cb + c + 4); }
        if (pos > 0) { const f32x4 w0 = *(const f32x4*)(cw + c), w1 = *(const f32x4*)(cw + c + 4); unpack8(*(const u32x4*)(AB + (size_t)(r - 1) * NUP + c), t0, t1); acc0 += t0 * w0; acc1 += t1 * w1; }
        if (pos < SEQ - 1) { const f32x4 w0 = *(const f32x4*)(cw + 2 * DFF + c), w1 = *(const f32x4*)(cw + 2 * DFF + c + 4); unpack8(*(const u32x4*)(AB + (size_t)(r + 1) * NUP + c), t0, t1); acc0 += t0 * w0; acc1 += t1 * w1; }
        unpack8(*(const u32x4*)(AB + (size_t)r * NUP + DFF + c), t0, t1);
        const f32x2 g0 = pg8::gelu_pk((f32x2){acc0[0], acc0[1]}), g1 = pg8::gelu_pk((f32x2){acc0[2], acc0[3]}), g2 = pg8::gelu_pk((f32x2){acc1[0], acc1[1]}), g3 = pg8::gelu_pk((f32x2){acc1[2], acc1[3]});
        const f32x4 o0 = (f32x4){g0.x, g0.y, g1.x, g1.y} * t0, o1 = (f32x4){g2.x, g2.y, g3.x, g3.y} * t1;
        *(u32x4*)(U + (size_t)r * DFF + c) = pack8(o0, o1);
    }
}
#ifndef MK_PHASES
#define MK_PHASES 0xFFFF
#endif
#define PH(k) if constexpr ((MK_PHASES >> (k)) & 1)
template <class Epi> __device__ __forceinline__ void run_gemm(unsigned char* lds, const bf16_t* A, const bf16_t* Bt, int N, int K, const Epi& E, const int wv_) {
    asm volatile("" : "+s"(K));
    pg8::Gemm g{A, Bt, T, N, K}; pg8::StaticOrder S; int Gd = gridDim.x, cb_ = blockIdx.x; asm volatile("" : "+s"(Gd), "+s"(cb_)); S.init(T, N, Gd, cb_);
    pg8::gemm_phase<Epi, pg8::StaticOrder, true, true>((PG8_LAS unsigned char*)lds, g, S, E, wv_);
}
#define XB_TMO      128
#define XB_XCNT(j)  (256  + 64 * (j))
#define XB_XSUB(j)  (1280 + 64 * (j))
#define XB_XGEN(j)  (2304 + 64 * (j))
#define XB_TOP      3328
#define XB_TOPGEN   3392
#define XCD_BAR_WORDS 3456
#define XB_SPIN_CAP (1u << 18)

__device__ __forceinline__ unsigned xb_ld(unsigned* p)              { return __hip_atomic_load(p, __ATOMIC_RELAXED, __HIP_MEMORY_SCOPE_AGENT); }
__device__ __forceinline__ unsigned xb_add(unsigned* p, unsigned v) { return __hip_atomic_fetch_add(p, v, __ATOMIC_RELAXED, __HIP_MEMORY_SCOPE_AGENT); }
__device__ __forceinline__ unsigned xb_xcc_id() { return (unsigned)__builtin_amdgcn_s_getreg((3 << 11) | 20) & 0xFu; }
#define XB_SPIN(cond, bar) do { unsigned _sp = 0; while (cond) { __builtin_amdgcn_s_sleep(1); \
    if ((++_sp & 255u) == 0u) { if (xb_ld(&(bar)[XB_TMO])) break; if (_sp > XB_SPIN_CAP) { atomicAdd(&(bar)[XB_TMO], 1u); break; } } } } while (0)

struct XcdBarrier {
    unsigned* bar; unsigned x; bool t0;
    volatile LAS unsigned* st;
};

__device__ __forceinline__ XcdBarrier xcd_barrier_post(unsigned* bar, volatile LAS unsigned* st) {
    XcdBarrier b; b.bar = bar; b.x = xb_xcc_id(); b.st = st;
    if (threadIdx.x == 0) (void)xb_add(&bar[XB_XCNT(b.x)], 1u);
    return b;
}
__device__ __forceinline__ void xcd_barrier_complete(unsigned* bar, unsigned x, unsigned& nloc, unsigned& nx) {
    const unsigned G = gridDim.x * gridDim.y * gridDim.z;
    unsigned sum, cnt, mine, sp = 0u;
    for (;;) {
        sum = 0u; cnt = 0u; mine = 0u;
#pragma unroll
        for (unsigned j = 0; j < 16; ++j) { const unsigned c = xb_ld(&bar[XB_XCNT(j)]); sum += c; cnt += (c > 0u) ? 1u : 0u; mine = (j == x) ? c : mine; }
        if (sum == G) break;
        __builtin_amdgcn_s_sleep(1);
        if ((++sp & 255u) == 0u) { if (xb_ld(&bar[XB_TMO])) break; if (sp > XB_SPIN_CAP) { atomicAdd(&bar[XB_TMO], 1u); break; } }
    }
    nloc = mine > 0u ? mine : 1u; nx = cnt > 0u ? cnt : 1u;
}

__device__ __forceinline__ void xcd_barrier(const XcdBarrier& b) {
    asm volatile("s_waitcnt vmcnt(0)" ::: "memory");
    __syncthreads();
    if (b.t0) {
        unsigned* bar = b.bar;
        __builtin_amdgcn_s_waitcnt(0);
        unsigned nloc = b.st[0], nx = b.st[1];
        if (nloc == 0u) { xcd_barrier_complete(bar, b.x, nloc, nx); b.st[0] = nloc; b.st[1] = nx; }
        const unsigned old = xb_add(&bar[XB_XSUB(b.x)], 1u);
        const unsigned gen = old / nloc;
        if (old + 1u == (gen + 1u) * nloc) {
            __builtin_amdgcn_fence(__ATOMIC_RELEASE, "agent");
            asm volatile("s_waitcnt vmcnt(0)" ::: "memory");
            const unsigned og = xb_add(&bar[XB_TOP], 1u);
            const unsigned tg = og / nx;
            if (og + 1u == (tg + 1u) * nx) xb_add(&bar[XB_TOPGEN], 1u);
            else XB_SPIN(xb_ld(&bar[XB_TOPGEN]) == tg, bar);
            __builtin_amdgcn_fence(__ATOMIC_ACQUIRE, "agent");
            xb_add(&bar[XB_XGEN(b.x)], 1u);
            asm volatile("s_waitcnt vmcnt(0)" ::: "memory");
        } else {
            XB_SPIN(xb_ld(&bar[XB_XGEN(b.x)]) == gen, bar);
            __builtin_amdgcn_fence(__ATOMIC_ACQUIRE, "agent");
            asm volatile("s_waitcnt vmcnt(0)" ::: "memory");
        }
    }
    __syncthreads();
}

typedef const __attribute__((address_space(4))) KP* KPC;
__global__ void __launch_bounds__(512) mega(KP p_arg) {
    extern __shared__ __attribute__((aligned(16))) unsigned char lds[];
    cg::grid_group grid = cg::this_grid();
    int s = 0; const int s_lo = p_arg.lo, s_hi = p_arg.hi; const int wv_k = __builtin_amdgcn_readfirstlane((int)(threadIdx.x >> 6));
    volatile LAS unsigned* bst = (volatile LAS unsigned*)((LAS unsigned char*)lds + (LDS_BYTES - 64));
    if (threadIdx.x < 2) bst[threadIdx.x] = 0u;
    __syncthreads();
    (void)xcd_barrier_post((unsigned*)p_arg.ws, bst);
#define STEP_BEGIN if (s >= s_lo && s < s_hi) { \
        KPC kp = (KPC)__builtin_amdgcn_kernarg_segment_ptr(); int l = l_, g = g_; asm volatile("" : "+s"(kp), "+s"(l), "+s"(g)); \
        if (s > s_lo) { if (s == s_lo + 1) grid.sync(); else { XcdBarrier bar_; bar_.bar = (unsigned*)kp->ws; bar_.x = xb_xcc_id(); { int ln_; asm volatile("v_mbcnt_lo_u32_b32 %0, -1, 0\n\tv_mbcnt_hi_u32_b32 %0, -1, %0" : "=v"(ln_)); bar_.t0 = (wv_k == 0) && (ln_ == 0); } bar_.st = (volatile LAS unsigned*)((LAS unsigned char*)lds + (LDS_BYTES - 64)); xcd_barrier(bar_); } } \
        int G = gridDim.x, cblk = blockIdx.x, wv = wv_k; asm volatile("" : "+s"(G), "+s"(cblk), "+s"(wv)); (void)G; (void)cblk; \
        KP p; _Pragma("unroll") for (int i_ = 0; i_ < N_INPUTS; ++i_) p.in[i_] = kp->in[i_]; p.out = kp->out; p.ws = kp->ws; p.lo = 0; p.hi = 0; unsigned char* ws = p.ws; \
        const unsigned char* wl = ws + WS_W + (size_t)l * W_LAYER; (void)wl; \
        const float* ada_l = (const float*)(ws + WS_ADA) + (size_t)l * NBATCH * 6144; (void)ada_l;     \
        const float* ada_g = ada_l + (size_t)(g * GSEQ) * 6144; (void)ada_g;                           \
        float* xg = p.out + (size_t)g * T * DM; (void)xg;
#define STEP_END } ++s;
    { const int l_ = 0, g_ = 0; STEP_BEGIN PH(0) prologue(p, (unsigned char*)lds, wv); STEP_END }
    for (int g_ = 0; g_ < NG; ++g_) {
        for (int l_ = 0; l_ < DEPTH; ++l_) {
            if (l_ == 0) { STEP_BEGIN PH(11) row_phase<0>(p, g, nullptr, nullptr, wv, ada_l); STEP_END }
            STEP_BEGIN PH(1) { EpiIn E; E.ws = ws; run_gemm(lds, (const bf16_t*)(ws + WS_H), (const bf16_t*)(wl + WO_IN), NIN, 1024, E, wv); } STEP_END
            STEP_BEGIN {
                PH(2) for (int L = cblk; L < 512; L += G) {
                    const int x = L & 7, j = L >> 3, qb = j & 7, bh = (j >> 3) * 8 + x, b = bh >> 3, h = (bh & 7) >> 1, dvh = bh & 1;
                    const float df = p.in[I_RDF][l * 4 + h], db = p.in[I_RDB][l * 4 + h];
                    FaArgs A; const size_t rb = (size_t)b * SEQ;
                    A.Q1 = (const bf16_t*)(ws + WS_QR) + rb * 512 + h * 128; A.Q2 = nullptr;
                    A.K1 = (const bf16_t*)(ws + WS_KR) + rb * 512 + h * 128; A.K2 = nullptr;
                    A.V = (const bf16_t*)(ws + WS_VR) + rb * 1024 + h * 256 + dvh * 128;
                    A.O = (bf16_t*)(ws + WS_RO) + rb * 1024 + h * 256 + dvh * 128; A.q0 = qb * 256;
                    A.lf2 = -log1pf(expf(-df)) * 1.4426950408889634f; A.nlb2 = log1pf(expf(-db)) * 1.4426950408889634f;
                    flash_unit<1>(A, (char*)lds, wv);
                }
                PH(12) { EpiUQ E; E.ws = ws; run_gemm(lds, (const bf16_t*)(ws + WS_DQ), (const bf16_t*)(wl + WO_UQ), 1536, 256, E, wv); }
                PH(14) { EpiUKV E; E.ws = ws; run_gemm(lds, (const bf16_t*)(ws + WS_DKV), (const bf16_t*)(wl + WO_UKV), 2048, 128, E, wv); }
            } STEP_END
            STEP_BEGIN {
                PH(3) for (int L = cblk; L < 512; L += G) {
                    const int x = L & 7, j = L >> 3, qb = j & 7, bh = (j >> 3) * 8 + x, b = bh >> 3, h = bh & 7;
                    FaArgs A; const size_t rb = (size_t)b * SEQ;
                    A.Q1 = (const bf16_t*)(ws + WS_QN) + rb * 1024 + h * 128; A.Q2 = (const bf16_t*)(ws + WS_QRP) + rb * 512 + h * 64;
                    A.K1 = (const bf16_t*)(ws + WS_KN) + rb * 1024 + h * 128; A.K2 = (const bf16_t*)(ws + WS_KROPE) + rb * 64;
                    A.V = (const bf16_t*)(ws + WS_VM) + rb * 1024 + h * 128;
                    A.O = (bf16_t*)(ws + WS_AO) + rb * 1024 + h * 128; A.q0 = qb * 256; A.lf2 = 0.f; A.nlb2 = 0.f;
                    flash_unit<0>(A, (char*)lds, wv);
                }
                PH(13) rogate_phase(p, p.in[I_GN] + l * 1024, wv);
            } STEP_END
            STEP_BEGIN {
                PH(4) { EpiMerge<true> E; E.ws = ws; run_gemm(lds, (const bf16_t*)(ws + WS_RO), (const bf16_t*)(wl + WO_RETO), 1024, 1024, E, wv); }
                PH(4) { EpiMerge<false> E; E.ws = ws; run_gemm(lds, (const bf16_t*)(ws + WS_AO), (const bf16_t*)(wl + WO_MLAO), 1024, 1024, E, wv); }
            } STEP_END
            STEP_BEGIN PH(5) { EpiRes E; E.x = xg; E.gate = ada_g + 2048; run_gemm(lds, (const bf16_t*)(ws + WS_MG), (const bf16_t*)(wl + WO_OUT), 1024, 1024, E, wv); } STEP_END
            STEP_BEGIN PH(6) row_phase<1>(p, g, p.in[I_LN1G] + l * DM, p.in[I_LN1B] + l * DM, wv, ada_l + 3072); STEP_END
            STEP_BEGIN PH(7) { EpiUp E; E.ws = ws; run_gemm(lds, (const bf16_t*)(ws + WS_H), (const bf16_t*)(wl + WO_UP), NUP, 1024, E, wv); } STEP_END
            STEP_BEGIN PH(8) conv_phase(p, p.in[I_CONVW] + (size_t)l * 3 * DFF, p.in[I_CONVB] + (size_t)l * DFF, wv); STEP_END
            STEP_BEGIN PH(9) { EpiRes E; E.x = xg; E.gate = ada_g + 5120; run_gemm(lds, (const bf16_t*)(ws + WS_U), (const bf16_t*)(wl + WO_DOWN), 1024, DFF, E, wv); } STEP_END
            STEP_BEGIN PH(10) row_phase<2>(p, g, p.in[I_LN2G] + l * DM, p.in[I_LN2B] + l * DM, wv, l + 1 < DEPTH ? ada_l + (size_t)NBATCH * 6144 : nullptr); STEP_END
        }
    }
#undef STEP_BEGIN
#undef STEP_END
}
}

extern "C" void kernel_launch(void* const* d_in, const int* in_sizes, int n_in, void* d_out, int out_size, void* d_ws, size_t ws_size, hipStream_t stream) {
    static int grid = 0;
    if (grid == 0) {
        if (n_in != mk::N_INPUTS || ws_size < mk::WS_END) { fprintf(stderr, "kernel_launch: unexpected n_in %d / ws %zu\n", n_in, ws_size); grid = -1; return; }
        int dev = 0, cus = 0, per_cu = 0;
        hipGetDevice(&dev); hipDeviceGetAttribute(&cus, hipDeviceAttributeMultiprocessorCount, dev);
        if (hipFuncSetAttribute((const void*)mk::mega, hipFuncAttributeMaxDynamicSharedMemorySize, mk::LDS_BYTES) != hipSuccess) { fprintf(stderr, "kernel_launch: hipFuncSetAttribute failed\n"); grid = -1; return; }
        if (hipOccupancyMaxActiveBlocksPerMultiprocessor(&per_cu, (const void*)mk::mega, 512, mk::LDS_BYTES) != hipSuccess || per_cu < 1) { fprintf(stderr, "kernel_launch: occupancy query says %d\n", per_cu); per_cu = 1; }
        (void)hipGetLastError();
        grid = cus * per_cu;
        fprintf(stderr, "kernel_launch: grid %d (cus %d x %d)\n", grid, cus, per_cu);
    }
    if (grid < 0) return;
    mk::KP p{};
    for (int i = 0; i < mk::N_INPUTS; ++i) p.in[i] = (const float*)d_in[i];
    p.out = (float*)d_out; p.ws = (unsigned char*)d_ws; p.lo = 0; p.hi = 1 << 30;
    if (hipMemsetAsync(d_ws, 0, 16384, stream) != hipSuccess) { fprintf(stderr, "kernel_launch: memset failed\n"); return; }
    void* args[] = {&p};
    hipError_t e = hipLaunchCooperativeKernel((const void*)mk::mega, dim3(grid), dim3(512), args, mk::LDS_BYTES, stream);
    if (e != hipSuccess) fprintf(stderr, "kernel_launch: cooperative launch failed: %s (grid %d)\n", hipGetErrorString(e), grid);
}
```
